# Optimizing an MI355X kernel written in HIP

```python
import jax, jax.numpy as jnp
from jax import lax
import numpy as np

D_MODEL = 1024
BATCH = 8
SEQ = 4096
DEPTH = 2

GRID_W = 64
D_MIX = D_MODEL
D_MLSTM = D_MIX // 2
D_NA = D_MIX - D_MLSTM
MLSTM_HEADS = 4
MLSTM_HD = D_MLSTM // MLSTM_HEADS
NA_HEADS = 8
NA_HD = D_NA // NA_HEADS
CHUNK = 64
CONV_K = 3
NA_KH_MAX = 8
NA_KW = 16
D_FF = 4 * D_MODEL
N_GATES = 4 * MLSTM_HEADS
D_IN = 4 * D_MLSTM + N_GATES + 3 * D_NA
EPS = 1e-6

kernel_name = "hybrid_mlstm_natten_encoder"


def rms_norm(x, w):
    xf = x.astype(jnp.float32)
    y = xf * lax.rsqrt(jnp.mean(xf * xf, axis=-1, keepdims=True) + EPS)
    return (y * w.astype(jnp.float32)).astype(x.dtype)


def centered_dwconv(x, w, b):
    c = x.shape[-1]
    y = lax.conv_general_dilated(
        x, w[:, None, :].astype(x.dtype), window_strides=(1,),
        padding=[(CONV_K // 2, CONV_K // 2)],
        dimension_numbers=("NWC", "WIO", "NWC"), feature_group_count=c)
    return y + b.astype(x.dtype)


def mlstm_chunkwise(q, k, v, i_pre, f_pre):
    bsz, nh, s, dh = q.shape
    nc = s // CHUNK
    q = q.reshape(bsz, nh, nc, CHUNK, dh)
    k = k.reshape(bsz, nh, nc, CHUNK, dh) * (dh ** -0.5)
    v = v.reshape(bsz, nh, nc, CHUNK, dh)
    logf = jax.nn.log_sigmoid(f_pre).reshape(bsz, nh, nc, CHUNK)
    ig = i_pre.reshape(bsz, nh, nc, CHUNK)
    b = jnp.cumsum(logf, axis=-1)
    total = b[..., -1]

    a = total[..., None] - b + ig
    m_loc = jnp.max(a, axis=-1)
    wa = jnp.exp(a - m_loc[..., None])
    c_loc = jnp.einsum("bhnlv,bhnlk->bhnvk", wa[..., None] * v, k)
    n_loc = jnp.einsum("bhnl,bhnlk->bhnk", wa, k)

    def step(carry, inp):
        c_st, n_st, m_st = carry
        tot, ml, cl, nl = inp
        m_new = jnp.maximum(tot + m_st, ml)
        s_old = jnp.exp(tot + m_st - m_new)
        s_loc = jnp.exp(ml - m_new)
        c_new = s_old[..., None, None] * c_st + s_loc[..., None, None] * cl
        n_new = s_old[..., None] * n_st + s_loc[..., None] * nl
        return (c_new, n_new, m_new), (c_st, n_st, m_st)

    init = (jnp.zeros((bsz, nh, dh, dh), jnp.float32),
            jnp.zeros((bsz, nh, dh), jnp.float32),
            jnp.zeros((bsz, nh), jnp.float32))
    xs = (jnp.moveaxis(total, 2, 0), jnp.moveaxis(m_loc, 2, 0),
          jnp.moveaxis(c_loc, 2, 0), jnp.moveaxis(n_loc, 2, 0))
    _, (c_prev, n_prev, m_prev) = lax.scan(step, init, xs)
    c_prev = jnp.moveaxis(c_prev, 0, 2)
    n_prev = jnp.moveaxis(n_prev, 0, 2)
    m_prev = jnp.moveaxis(m_prev, 0, 2)

    tri = jnp.tril(jnp.ones((CHUNK, CHUNK), dtype=bool))
    dmat = b[..., :, None] - b[..., None, :] + ig[..., None, :]
    dmat = jnp.where(tri, dmat, -jnp.inf)
    inter = b + m_prev[..., None]
    m = jnp.maximum(inter, jnp.max(dmat, axis=-1))
    w_inter = jnp.exp(inter - m)
    p = jnp.exp(dmat - m[..., None]) * jnp.einsum("bhnjd,bhnsd->bhnjs", q, k)
    num = (w_inter[..., None] * jnp.einsum("bhnvk,bhnjk->bhnjv", c_prev, q)
           + jnp.einsum("bhnjs,bhnsv->bhnjv", p, v))
    den = w_inter * jnp.einsum("bhnk,bhnjk->bhnj", n_prev, q) + jnp.sum(p, axis=-1)
    h = num / jnp.maximum(jnp.abs(den), jnp.exp(-m))[..., None]
    return h.reshape(bsz, nh, s, dh)


def mlstm_mixer(q, k, v, o_pre, gates, gate_b, norm_w):
    bsz, s, _ = v.shape
    f32 = jnp.float32

    def heads(t):
        return t.astype(f32).reshape(bsz, s, MLSTM_HEADS, MLSTM_HD).transpose(0, 2, 1, 3)

    qh, kh, vh = heads(q), heads(k), heads(v)
    g = (gates.astype(f32) + gate_b.astype(f32)).reshape(bsz, s, 4, MLSTM_HEADS)
    g = g.transpose(2, 0, 3, 1)
    h_fwd = mlstm_chunkwise(qh, kh, vh, g[0], g[1])

    def flip(t):
        return jnp.flip(t, axis=2)

    h_bwd = flip(mlstm_chunkwise(flip(qh), flip(kh), flip(vh), flip(g[2]), flip(g[3])))
    h = h_fwd + h_bwd
    h = h * lax.rsqrt(jnp.mean(h * h, axis=-1, keepdims=True) + EPS)
    h = h.transpose(0, 2, 1, 3).reshape(bsz, s, D_MLSTM) * norm_w.astype(f32)
    return (jax.nn.sigmoid(o_pre.astype(f32)) * h).astype(v.dtype)


def neighbourhood_attention(q, k, v, rpb):
    bsz, s, _ = q.shape
    rows = s // GRID_W
    kh = min(NA_KH_MAX, rows)

    def grid(t):
        return t.reshape(bsz, rows, GRID_W, NA_HEADS, NA_HD)

    qg = grid(q) * (NA_HD ** -0.5)
    kg, vg = grid(k), grid(v)
    cols = np.arange(GRID_W)
    c_start = np.clip(cols - NA_KW // 2, 0, GRID_W - NA_KW)
    col_idx = c_start[:, None] + np.arange(NA_KW)[None, :]
    rel_c = col_idx - cols[:, None] + NA_KW - 1
    rpb_c = rpb[:, :, rel_c]

    def row_block(args):
        r, q_row = args
        rs = jnp.clip(r - kh // 2, 0, rows - kh)
        k_band = lax.dynamic_slice_in_dim(kg, rs, kh, axis=1)
        v_band = lax.dynamic_slice_in_dim(vg, rs, kh, axis=1)
        k_win = k_band[:, :, col_idx]
        v_win = v_band[:, :, col_idx]
        rel_r = rs + jnp.arange(kh) - r + NA_KH_MAX - 1
        bias = rpb_c[:, rel_r].transpose(0, 2, 1, 3)
        sc = jnp.einsum("bchd,brcwhd->bhcrw", q_row, k_win).astype(jnp.float32)
        sc = sc + bias[None].astype(jnp.float32)
        p = jax.nn.softmax(sc.reshape(bsz, NA_HEADS, GRID_W, kh * NA_KW), axis=-1)
        p = p.reshape(bsz, NA_HEADS, GRID_W, kh, NA_KW).astype(v.dtype)
        return jnp.einsum("bhcrw,brcwhd->bchd", p, v_win)

    out = lax.map(row_block, (jnp.arange(rows), jnp.moveaxis(qg, 1, 0)))
    return jnp.moveaxis(out, 0, 1).reshape(bsz, s, D_NA)


def setup_inputs(seed: int = 0) -> dict:
    key = jax.random.key(seed)
    ks = jax.random.split(key, 16)

    def nrm(k, shape, scale):
        return jax.random.normal(k, shape, jnp.float32) * scale

    x = nrm(ks[0], (BATCH, SEQ, D_MODEL), 1.0)
    norm1_w = 1.0 + nrm(ks[1], (DEPTH, D_MODEL), 0.02)
    w_in = nrm(ks[2], (DEPTH, D_MODEL, D_IN), D_MODEL ** -0.5)
    conv_w = nrm(ks[3], (DEPTH, CONV_K, 2 * D_MLSTM), CONV_K ** -0.5)
    conv_b = nrm(ks[4], (DEPTH, 2 * D_MLSTM), 0.02)
    f_bias = jnp.linspace(3.0, 6.0, MLSTM_HEADS, dtype=jnp.float32)
    i_bias = jnp.zeros((MLSTM_HEADS,), jnp.float32)
    base = jnp.concatenate([i_bias, f_bias, i_bias, f_bias])
    gate_b = base[None, :] + nrm(ks[5], (DEPTH, N_GATES), 0.1)
    mlstm_norm_w = 1.0 + nrm(ks[6], (DEPTH, D_MLSTM), 0.02)
    rpb = nrm(ks[7], (DEPTH, NA_HEADS, 2 * NA_KH_MAX - 1, 2 * NA_KW - 1), 0.1)
    w_out = nrm(ks[8], (DEPTH, D_MIX, D_MODEL), D_MIX ** -0.5)
    norm2_w = 1.0 + nrm(ks[9], (DEPTH, D_MODEL), 0.02)
    w_ff1 = nrm(ks[10], (DEPTH, D_MODEL, D_FF), D_MODEL ** -0.5)
    w_ff2 = nrm(ks[11], (DEPTH, D_FF, D_MODEL), D_FF ** -0.5)
    final_norm_w = 1.0 + nrm(ks[12], (D_MODEL,), 0.02)
    return {"x": x, "norm1_w": norm1_w, "w_in": w_in, "conv_w": conv_w, "conv_b": conv_b,
            "gate_b": gate_b, "mlstm_norm_w": mlstm_norm_w, "rpb": rpb, "w_out": w_out,
            "norm2_w": norm2_w, "w_ff1": w_ff1, "w_ff2": w_ff2, "final_norm_w": final_norm_w}


def reference(x, norm1_w, w_in, conv_w, conv_b, gate_b, mlstm_norm_w, rpb, w_out,
              norm2_w, w_ff1, w_ff2, final_norm_w):
    splits = np.cumsum([D_MLSTM, D_MLSTM, D_MLSTM, D_MLSTM, N_GATES, D_NA, D_NA]).tolist()
    for l in range(DEPTH):
        h = rms_norm(x, norm1_w[l])
        proj = h @ w_in[l]
        q_m, k_m, v_m, o_m, gates, q_n, k_n, v_n = jnp.split(proj, splits, axis=-1)
        qk = jax.nn.silu(centered_dwconv(jnp.concatenate([q_m, k_m], axis=-1), conv_w[l], conv_b[l]))
        q_m, k_m = qk[..., :D_MLSTM], qk[..., D_MLSTM:]
        y_m = mlstm_mixer(q_m, k_m, v_m, o_m, gates, gate_b[l], mlstm_norm_w[l])
        y_n = neighbourhood_attention(q_n, k_n, v_n, rpb[l])
        y = jnp.concatenate([y_m.astype(x.dtype), y_n.astype(x.dtype)], axis=-1)
        x = x + y @ w_out[l]
        h = rms_norm(x, norm2_w[l])
        x = x + jnp.square(jax.nn.relu(h @ w_ff1[l])) @ w_ff2[l]
    return rms_norm(x, final_norm_w)
```

```cpp
#include <hip/hip_runtime.h>
#include <hip/hip_cooperative_groups.h>
#include <cstdio>
namespace cg = cooperative_groups;

#ifndef MULTI_LAUNCH
#define MULTI_LAUNCH 0
#endif
#ifndef PHASE_MASK
#define PHASE_MASK 0xffff
#endif
#define PH_ON(k) ((PHASE_MASK >> (k)) & 1)
#ifndef REPEAT_MASK
#define REPEAT_MASK 0
#endif
#define REP(k) ((REPEAT_MASK >> (k)) & 1)

#define LAS __attribute__((address_space(3)))
typedef unsigned short bf16_t;
typedef short bf16x8 __attribute__((ext_vector_type(8)));
typedef short s16x4 __attribute__((ext_vector_type(4)));
typedef float f32x4 __attribute__((ext_vector_type(4)));
typedef unsigned u32x4 __attribute__((ext_vector_type(4)));
typedef unsigned u32x2 __attribute__((ext_vector_type(2)));
typedef unsigned ssq_t;
__device__ __forceinline__ ssq_t ssq_enc(float s) { return (ssq_t)(s * 1024.0f + 0.5f); }
__device__ __forceinline__ float ssq_dec(ssq_t v) { return (float)v * (1.0f / 1024.0f); }

constexpr int MROWS = 32768, DM = 1024, SEQ = 4096, NPROJ = 3584, NINP = 3840, DFF = 4096, HLD = 4160;
constexpr int LDS_BYTES = 163840;
constexpr float EPS = 1e-6f;

constexpr size_t WS_WIN = 0;
constexpr size_t WS_WOUT = WS_WIN + (size_t)2 * NINP * DM * 2;
constexpr size_t WS_WFF1 = WS_WOUT + (size_t)2 * DM * DM * 2;
constexpr size_t WS_WFF2 = WS_WFF1 + (size_t)2 * DFF * DM * 2;
constexpr size_t WS_XB = WS_WFF2 + (size_t)2 * DM * DFF * 2;
constexpr size_t WS_G = WS_XB + (size_t)MROWS * DM * 2;
constexpr size_t WS_SSQ = WS_G + (size_t)MROWS * 16 * 4;
constexpr size_t WS_R1 = WS_SSQ + (size_t)5 * MROWS * 8;
constexpr size_t WS_BAR = WS_R1 + (size_t)MROWS * HLD * 2;
constexpr size_t WS_PBUF = WS_BAR + 16384;
constexpr size_t WS_SCAL = WS_PBUF + (size_t)4096 * 8192;
constexpr size_t WS_QKC = WS_SCAL + (size_t)4096 * 192 * 4;
constexpr size_t WS_END = WS_QKC + (size_t)MROWS * DM * 2;

struct Params {
    const float* x; const float* norm1_w; const float* w_in; const float* conv_w; const float* conv_b; const float* gate_b;
    const float* mnorm_w; const float* rpb; const float* w_out; const float* norm2_w; const float* w_ff1; const float* w_ff2; const float* fnorm_w;
    float* out; unsigned char* ws; int ph_lo, ph_hi;
};

typedef __bf16 bf16x2_t __attribute__((ext_vector_type(2)));
__device__ __forceinline__ unsigned cvt_pk_bf16(float lo, float hi) { bf16x2_t v; v[0] = (__bf16)lo; v[1] = (__bf16)hi; return __builtin_bit_cast(unsigned, v); }
__device__ __forceinline__ int opaque_tid() { int t = threadIdx.x; asm volatile("" : "+v"(t)); return t; }
__device__ __forceinline__ float bf_lo(unsigned w) { return __uint_as_float(w << 16); }
__device__ __forceinline__ float bf_hi(unsigned w) { return __uint_as_float(w & 0xffff0000u); }
__device__ __forceinline__ s16x4 tr_read(LAS unsigned char* p) { return __builtin_amdgcn_ds_read_tr16_b64_v4i16((LAS s16x4*)p); }
__device__ __forceinline__ bf16x8 cat4(s16x4 a, s16x4 b) { bf16x8 r; r[0] = a[0]; r[1] = a[1]; r[2] = a[2]; r[3] = a[3]; r[4] = b[0]; r[5] = b[1]; r[6] = b[2]; r[7] = b[3]; return r; }
#define LDS_BARRIER() do { asm volatile("s_waitcnt lgkmcnt(0)" ::: "memory"); __builtin_amdgcn_s_barrier(); asm volatile("" ::: "memory"); } while (0)
__device__ __forceinline__ f32x4 mfma16(bf16x8 a, bf16x8 b, f32x4 c) { return __builtin_amdgcn_mfma_f32_16x16x32_bf16(a, b, c, 0, 0, 0); }


#define XB_TMO      128
#define XB_XCNT(j)  (256  + 64 * (j))
#define XB_XSUB(j)  (1280 + 64 * (j))
#define XB_XGEN(j)  (2304 + 64 * (j))
#define XB_TOP      3328
#define XB_TOPGEN   3392
#define XCD_BAR_WORDS 3456
#define XB_SPIN_CAP (1u << 22)
__device__ __forceinline__ unsigned xb_ld(unsigned* p)              { return __hip_atomic_load(p, __ATOMIC_RELAXED, __HIP_MEMORY_SCOPE_AGENT); }
__device__ __forceinline__ unsigned xb_add(unsigned* p, unsigned v) { return __hip_atomic_fetch_add(p, v, __ATOMIC_RELAXED, __HIP_MEMORY_SCOPE_AGENT); }
__device__ __forceinline__ unsigned xb_xcc_id() { return (unsigned)__builtin_amdgcn_s_getreg((3 << 11) | 20) & 0xFu; }
#define XB_SPIN(cond, bar) do { unsigned _sp = 0; while (cond) { __builtin_amdgcn_s_sleep(1); \
    if ((++_sp & 255u) == 0u) { if (xb_ld(&(bar)[XB_TMO])) break; if (_sp > XB_SPIN_CAP) { atomicAdd(&(bar)[XB_TMO], 1u); break; } } } } while (0)
struct XcdBarrier { unsigned* bar; unsigned x; volatile LAS unsigned* st; };
__device__ __forceinline__ XcdBarrier xcd_barrier_post(unsigned* bar, volatile LAS unsigned* st) {
    XcdBarrier b; b.bar = bar; b.x = xb_xcc_id(); b.st = st;
    if (threadIdx.x == 0) (void)xb_add(&bar[XB_XCNT(b.x)], 1u);
    return b;
}
__device__ __forceinline__ void xcd_barrier_complete(unsigned* bar, unsigned x, unsigned& nloc, unsigned& nx) {
    const unsigned G = gridDim.x * gridDim.y * gridDim.z;
    unsigned sum, cnt, mine, sp = 0u;
    for (;;) {
        sum = 0u; cnt = 0u; mine = 0u;
#pragma unroll
        for (unsigned j = 0; j < 16; ++j) { const unsigned c = xb_ld(&bar[XB_XCNT(j)]); sum += c; cnt += (c > 0u) ? 1u : 0u; mine = (j == x) ? c : mine; }
        if (sum == G) break;
        __builtin_amdgcn_s_sleep(1);
        if ((++sp & 255u) == 0u) { if (xb_ld(&bar[XB_TMO])) break; if (sp > XB_SPIN_CAP) { atomicAdd(&bar[XB_TMO], 1u); break; } }
    }
    nloc = mine > 0u ? mine : 1u; nx = cnt > 0u ? cnt : 1u;
}
__device__ __forceinline__ void xcd_barrier(const XcdBarrier& b) {
    asm volatile("s_waitcnt vmcnt(0)" ::: "memory");
    __syncthreads();
    if (threadIdx.x == 0) {
        unsigned* bar = b.bar;
        __builtin_amdgcn_s_waitcnt(0);
        unsigned nloc = b.st[0], nx = b.st[1];
        if (nloc == 0u) { xcd_barrier_complete(bar, b.x, nloc, nx); b.st[0] = nloc; b.st[1] = nx; }
        const unsigned old = xb_add(&bar[XB_XSUB(b.x)], 1u);
        const unsigned gen = old / nloc;
        if (old + 1u == (gen + 1u) * nloc) {
            __builtin_amdgcn_fence(__ATOMIC_RELEASE, "agent");
            asm volatile("s_waitcnt vmcnt(0)" ::: "memory");
            const unsigned og = xb_add(&bar[XB_TOP], 1u);
            const unsigned tg = og / nx;
            if (og + 1u == (tg + 1u) * nx) xb_add(&bar[XB_TOPGEN], 1u);
            else XB_SPIN(xb_ld(&bar[XB_TOPGEN]) == tg, bar);
            __builtin_amdgcn_fence(__ATOMIC_ACQUIRE, "agent");
            xb_add(&bar[XB_XGEN(b.x)], 1u);
            asm volatile("s_waitcnt vmcnt(0)" ::: "memory");
        } else {
            XB_SPIN(xb_ld(&bar[XB_XGEN(b.x)]) == gen, bar);
            __builtin_amdgcn_fence(__ATOMIC_ACQUIRE, "agent");
            asm volatile("s_waitcnt vmcnt(0)" ::: "memory");
        }
    }
    __syncthreads();
}

namespace pg8 {
constexpr int BM = 256, BK = 64, HALF = 128, HTB = HALF * BK * 2, STAGE_BYTES = 8 * HTB, NXCD = 8, WGM = 8;
__device__ __forceinline__ int lds_byte(int r, int c) { const int st = (r >> 4) * 2 + (c >> 5), rr = r & 15, cc = c & 31, ob = rr * 64 + cc * 2; return st * 1024 + (ob ^ (((ob >> 9) & 1) << 5)); }
__device__ __forceinline__ void stage_rc(int b, int& R, int& C) { const int st = b / 1024, sb = b % 1024, swz = sb ^ (((sb >> 9) & 1) << 5); R = (st >> 1) * 16 + swz / 64; C = (st & 1) * 32 + (swz % 64) / 2; }
__device__ __forceinline__ int perm32(int rho) { const int n = rho >> 4, i = rho & 15; return 8 * (i >> 2) + 4 * n + (i & 3); }
struct Unit { int pm, pn; };
struct Gemm { const bf16_t* A; const bf16_t* Bt; int M, N, K, lda; };
struct StaticOrder {
    int nM, nN, nwg, G, c;
    __device__ void init(int M, int N, int G_, int c_) { nM = M / BM; nN = N / BM; nwg = nM * nN; G = G_; c = c_; }
    __device__ bool next(int i, Unit& u) const {
        const long L = (long)i * G + c; if (L >= nwg) return false;
        int wgid = (int)L; { const int q = nwg / NXCD, r = nwg % NXCD, xcd = wgid % NXCD, off = wgid / NXCD; wgid = (xcd < r ? xcd * (q + 1) : r * (q + 1) + (xcd - r) * q) + off; }
        const int nig = WGM * nN, gid = wgid / nig, fm = gid * WGM, gsz = (nM - fm) < WGM ? (nM - fm) : WGM;
        u.pm = fm + ((wgid % nig) % gsz); u.pn = (wgid % nig) / gsz; return true;
    }
};

struct EpiProj {
    bf16_t* P; float* G; const ssq_t* ssq;
    static constexpr bool HAS_PRE = true;
    __device__ __forceinline__ void pre(const Unit& u, int wr, int fr, ssq_t (&pv)[8]) const {
        const int row0 = u.pm * BM + wr * 64 + fr;
#pragma unroll
        for (int ai = 0; ai < 2; ++ai)
#pragma unroll
            for (int m = 0; m < 4; ++m) pv[ai * 4 + m] = ssq[row0 + ai * HALF + m * 16];
    }
    __device__ __forceinline__ void operator()(const f32x4 (&acc)[2][2][4][2], const Unit& u, int wr, int wc, int fr, int fq, const ssq_t (&pv)[8]) const {
        const int row0 = u.pm * BM + wr * 64 + fr;
#pragma unroll
        for (int ai = 0; ai < 2; ++ai)
#pragma unroll
            for (int m = 0; m < 4; ++m) {
                const int row = row0 + ai * HALF + m * 16;
                const float rs = rsqrtf(ssq_dec(pv[ai * 4 + m]) * (1.0f / DM) + EPS);
                bf16_t* rowp = P + (size_t)row * NPROJ + u.pn * BM + wc * 32 + 8 * fq;
#pragma unroll
                for (int bj = 0; bj < 2; ++bj) { const f32x4 v0 = acc[ai][bj][m][0] * rs, v1 = acc[ai][bj][m][1] * rs;
                    u32x4 w; w.x = cvt_pk_bf16(v0[0], v0[1]); w.y = cvt_pk_bf16(v0[2], v0[3]); w.z = cvt_pk_bf16(v1[0], v1[1]); w.w = cvt_pk_bf16(v1[2], v1[3]);
                    *(u32x4*)(rowp + bj * HALF) = w; }
            }
    }
};
struct EpiResid { static constexpr bool INPLACE = true;
    const float* XinF; const bf16_t* XinB; float* XoutF; bf16_t* XB; ssq_t* ssq;
    static constexpr bool HAS_PRE = false;
    __device__ __forceinline__ void pre(const Unit&, int, int, ssq_t (&)[8]) const {}
    __device__ __forceinline__ void operator()(const f32x4 (&acc)[2][2][4][2], const Unit& u, int wr, int wc, int fr, int fq, const ssq_t (&)[8]) const {
        const int row0 = u.pm * BM + wr * 64 + fr, col0 = u.pn * BM + wc * 32 + 8 * fq;
#pragma unroll
        for (int ai = 0; ai < 2; ++ai) {
            f32x4 xo[4][2][2];
            if (XinF) {
#pragma unroll
                for (int m = 0; m < 4; ++m)
#pragma unroll
                    for (int bj = 0; bj < 2; ++bj) { const size_t off = (size_t)(row0 + ai * HALF + m * 16) * DM + col0 + bj * HALF; xo[m][bj][0] = *(const f32x4*)(XinF + off); xo[m][bj][1] = *(const f32x4*)(XinF + off + 4); }
            } else {
                u32x4 xb[4][2];
#pragma unroll
                for (int m = 0; m < 4; ++m)
#pragma unroll
                    for (int bj = 0; bj < 2; ++bj) xb[m][bj] = *(const u32x4*)(XinB + (size_t)(row0 + ai * HALF + m * 16) * DM + col0 + bj * HALF);
#pragma unroll
                for (int m = 0; m < 4; ++m)
#pragma unroll
                    for (int bj = 0; bj < 2; ++bj) { const u32x4 t = xb[m][bj]; xo[m][bj][0] = (f32x4){bf_lo(t.x), bf_hi(t.x), bf_lo(t.y), bf_hi(t.y)}; xo[m][bj][1] = (f32x4){bf_lo(t.z), bf_hi(t.z), bf_lo(t.w), bf_hi(t.w)}; }
            }
#pragma unroll
            for (int m = 0; m < 4; ++m) {
                const int row = row0 + ai * HALF + m * 16; float s = 0.f;
#pragma unroll
                for (int bj = 0; bj < 2; ++bj) { const size_t off = (size_t)row * DM + col0 + bj * HALF;
                    const f32x4 v0 = xo[m][bj][0] + acc[ai][bj][m][0], v1 = xo[m][bj][1] + acc[ai][bj][m][1];
                    if (XoutF) { *(f32x4*)(XoutF + off) = v0; *(f32x4*)(XoutF + off + 4) = v1; }
                    if (XB) { u32x4 w; w.x = cvt_pk_bf16(v0[0], v0[1]); w.y = cvt_pk_bf16(v0[2], v0[3]); w.z = cvt_pk_bf16(v1[0], v1[1]); w.w = cvt_pk_bf16(v1[2], v1[3]);
                        *(u32x4*)(XB + off) = w; }
                    s += (v0[0] * v0[0] + v0[1] * v0[1]) + (v0[2] * v0[2] + v0[3] * v0[3]) + (v1[0] * v1[0] + v1[1] * v1[1]) + (v1[2] * v1[2] + v1[3] * v1[3]); }
                s += __shfl_xor(s, 16); s += __shfl_xor(s, 32);
                if (fq == 0) atomicAdd(ssq + row, ssq_enc(s));
            }
        }
    }
};
struct EpiFF1 {
    bf16_t* H; const ssq_t* ssq;
    static constexpr bool HAS_PRE = true;
    __device__ __forceinline__ void pre(const Unit& u, int wr, int fr, ssq_t (&pv)[8]) const {
        const int row0 = u.pm * BM + wr * 64 + fr;
#pragma unroll
        for (int ai = 0; ai < 2; ++ai)
#pragma unroll
            for (int m = 0; m < 4; ++m) pv[ai * 4 + m] = ssq[row0 + ai * HALF + m * 16];
    }
    __device__ __forceinline__ void operator()(const f32x4 (&acc)[2][2][4][2], const Unit& u, int wr, int wc, int fr, int fq, const ssq_t (&pv)[8]) const {
        const int row0 = u.pm * BM + wr * 64 + fr, col0 = u.pn * BM + wc * 32 + 8 * fq;
#pragma unroll
        for (int ai = 0; ai < 2; ++ai)
#pragma unroll
            for (int m = 0; m < 4; ++m) {
                const int row = row0 + ai * HALF + m * 16;
                const float rs = rsqrtf(ssq_dec(pv[ai * 4 + m]) * (1.0f / DM) + EPS);
                bf16_t* rowp = H + (size_t)row * HLD + col0;
#pragma unroll
                for (int bj = 0; bj < 2; ++bj) { f32x4 v0 = acc[ai][bj][m][0] * rs, v1 = acc[ai][bj][m][1] * rs;
#pragma unroll
                    for (int j = 0; j < 4; ++j) { const float a = fmaxf(v0[j], 0.f), b = fmaxf(v1[j], 0.f); v0[j] = a * a; v1[j] = b * b; }
                    u32x4 w; w.x = cvt_pk_bf16(v0[0], v0[1]); w.y = cvt_pk_bf16(v0[2], v0[3]); w.z = cvt_pk_bf16(v1[0], v1[1]); w.w = cvt_pk_bf16(v1[2], v1[3]);
                    *(u32x4*)(rowp + bj * HALF) = w; }
            }
    }
};

template <class Epi>
__device__ __forceinline__ void gemm_phase(LAS unsigned char* lds, const Gemm g, const StaticOrder& S, const Epi& E) {
    const int tid = opaque_tid(), wid = __builtin_amdgcn_readfirstlane(tid >> 6), lane = tid & 63, wr = wid >> 2, wc = wid & 3, fr = lane & 15, fq = lane >> 4;
    const int K = g.K, nt = K / BK, lda = g.lda;
    unsigned voffA[2], voffB[2];
#pragma unroll
    for (int i = 0; i < 2; ++i) { int R, C; stage_rc(tid * 16 + i * 8192, R, C); const int Rb = (R & ~31) + perm32(R & 31);
        voffA[i] = (unsigned)(R * lda + C) * 2u; voffB[i] = (unsigned)(Rb * K + C) * 2u; }
    const size_t kstep = (size_t)(BK * 2);
    const size_t hstepA = (size_t)HALF * lda * 2, hstepB = (size_t)HALF * K * 2;
    const size_t tstepA = 2 * hstepA, tstepB = 2 * hstepB;
    const unsigned ldsw = (unsigned)wid * 1024u;
    const int aoff = lds_byte(wr * 64 + fr, fq * 8), boff = lds_byte(wc * 32 + fr, fq * 8);
#define PG8_SA(b, h) (((b) * 2 + (h)) * HTB)
#define PG8_SB(b, h) ((4 + (b) * 2 + (h)) * HTB)
#define PG8_STAGE(bufoff, gbase, voff) do { _Pragma("unroll") for (int _i = 0; _i < 2; ++_i) \
        __builtin_amdgcn_global_load_lds((const unsigned*)((const char*)(gbase) + (voff)[_i]), (LAS unsigned*)(lds + (bufoff) + ldsw + _i * 8192), 16, 0, 0); } while (0)
#define PG8_LDA(dst, b, h) do { _Pragma("unroll") for (int m = 0; m < 4; ++m) _Pragma("unroll") for (int k = 0; k < 2; ++k) dst[m][k] = *(const LAS bf16x8*)(lds + PG8_SA(b, h) + aoff + m * 2048 + k * 1024); } while (0)
#define PG8_LDB(dst, b, h) do { _Pragma("unroll") for (int n = 0; n < 2; ++n) _Pragma("unroll") for (int k = 0; k < 2; ++k) dst[n][k] = *(const LAS bf16x8*)(lds + PG8_SB(b, h) + boff + n * 2048 + k * 1024); } while (0)
#define PG8_MMA(ai, bj, At, Bt) do { __builtin_amdgcn_s_setprio(1); _Pragma("unroll") for (int m = 0; m < 4; ++m) _Pragma("unroll") for (int n = 0; n < 2; ++n) _Pragma("unroll") for (int k = 0; k < 2; ++k) \
        acc[ai][bj][m][n] = __builtin_amdgcn_mfma_f32_16x16x32_bf16(Bt[n][k], At[m][k], acc[ai][bj][m][n], 0, 0, 0); __builtin_amdgcn_s_setprio(0); } while (0)
#define PG8_WAIT_V(n) asm volatile("s_waitcnt vmcnt(" #n ")" ::: "memory")
#define PG8_WAIT_L(n) asm volatile("s_waitcnt lgkmcnt(" #n ")" ::: "memory")
#define PG8_BAR __builtin_amdgcn_s_barrier()
#define PG8_SCHED __builtin_amdgcn_sched_barrier(0)
    Unit cur, nxt; int ui = 0;
    if (!S.next(0, cur)) return;
    f32x4 acc[2][2][4][2];
#pragma unroll
    for (int a = 0; a < 2; ++a)
#pragma unroll
        for (int b = 0; b < 2; ++b)
#pragma unroll
            for (int m = 0; m < 4; ++m)
#pragma unroll
                for (int n = 0; n < 2; ++n) acc[a][b][m][n] = (f32x4){0.f, 0.f, 0.f, 0.f};
    bf16x8 At[4][2], B0[2][2], B1[2][2];
    ssq_t pv[8] = {0u, 0u, 0u, 0u, 0u, 0u, 0u, 0u};
    const char* cA = (const char*)g.A + (size_t)cur.pm * tstepA; const char* cB = (const char*)g.Bt + (size_t)cur.pn * tstepB;
    PG8_STAGE(PG8_SB(0, 0), cB, voffB); PG8_STAGE(PG8_SA(0, 0), cA, voffA); PG8_STAGE(PG8_SB(0, 1), cB + hstepB, voffB); PG8_STAGE(PG8_SA(0, 1), cA + hstepA, voffA);
    if (wr == 1) PG8_BAR;
    PG8_WAIT_V(4); PG8_BAR;
    PG8_STAGE(PG8_SB(1, 0), cB + kstep, voffB); PG8_STAGE(PG8_SA(1, 0), cA + kstep, voffA); PG8_STAGE(PG8_SB(1, 1), cB + hstepB + kstep, voffB);
    PG8_WAIT_V(6); PG8_BAR;
    for (;;) {
        const bool has_next = S.next(ui + 1, nxt);
        const char* nA = has_next ? (const char*)g.A + (size_t)nxt.pm * tstepA : cA; const char* nB = has_next ? (const char*)g.Bt + (size_t)nxt.pn * tstepB : cB;
        for (int t = 0; t < nt; t += 2) {
            const bool last = (t == nt - 2);
            const char* a1 = cA + (size_t)(t + 1) * kstep;
            const char* a2 = last ? nA : cA + (size_t)(t + 2) * kstep; const char* b2 = last ? nB : cB + (size_t)(t + 2) * kstep;
            const char* a3 = a2 + kstep; const char* b3 = b2 + kstep;
            if (Epi::HAS_PRE && last) E.pre(cur, wr, fr, pv);
            PG8_LDB(B0, 0, 0); PG8_SCHED; PG8_LDA(At, 0, 0); PG8_STAGE(PG8_SA(1, 1), a1 + hstepA, voffA);
            PG8_WAIT_L(8); PG8_BAR; PG8_WAIT_L(0); PG8_MMA(0, 0, At, B0); PG8_BAR; PG8_SCHED;
            PG8_LDB(B1, 0, 1); PG8_STAGE(PG8_SB(0, 0), b2, voffB);
            PG8_BAR; PG8_WAIT_L(0); PG8_MMA(0, 1, At, B1); PG8_BAR;
            PG8_LDA(At, 0, 1); PG8_STAGE(PG8_SA(0, 0), a2, voffA);
            PG8_BAR; PG8_WAIT_L(0); PG8_MMA(1, 0, At, B0); PG8_BAR; PG8_SCHED;
            PG8_STAGE(PG8_SB(0, 1), b2 + hstepB, voffB);
            PG8_WAIT_V(6); PG8_BAR; PG8_MMA(1, 1, At, B1); PG8_BAR;
            PG8_LDB(B0, 1, 0); PG8_SCHED; PG8_LDA(At, 1, 0); PG8_STAGE(PG8_SA(0, 1), a2 + hstepA, voffA);
            PG8_WAIT_L(8); PG8_BAR; PG8_WAIT_L(0); PG8_MMA(0, 0, At, B0); PG8_BAR; PG8_SCHED;
            PG8_LDB(B1, 1, 1); PG8_STAGE(PG8_SB(1, 0), b3, voffB);
            PG8_BAR; PG8_WAIT_L(0); PG8_MMA(0, 1, At, B1); PG8_BAR;
            PG8_LDA(At, 1, 1); PG8_STAGE(PG8_SA(1, 0), a3, voffA);
            PG8_BAR; PG8_WAIT_L(0); PG8_MMA(1, 0, At, B0); PG8_BAR; PG8_SCHED;
            PG8_STAGE(PG8_SB(1, 1), b3 + hstepB, voffB);
            PG8_WAIT_V(6); PG8_BAR; PG8_MMA(1, 1, At, B1); PG8_BAR;
        }
        E(acc, cur, wr, wc, fr, fq, pv);
        if (!has_next) break;
#pragma unroll
        for (int a = 0; a < 2; ++a)
#pragma unroll
            for (int b = 0; b < 2; ++b)
#pragma unroll
                for (int m = 0; m < 4; ++m)
#pragma unroll
                    for (int n = 0; n < 2; ++n) acc[a][b][m][n] = (f32x4){0.f, 0.f, 0.f, 0.f};
        cur = nxt; cA = nA; cB = nB; ++ui;
    }
    PG8_WAIT_V(0);
    if (wr == 0) PG8_BAR;
    PG8_BAR;
#undef PG8_SA
#undef PG8_SB
#undef PG8_STAGE
#undef PG8_LDA
#undef PG8_LDB
#undef PG8_MMA
#undef PG8_WAIT_V
#undef PG8_WAIT_L
#undef PG8_BAR
#undef PG8_SCHED
}
}

struct WtDesc { const float* src; const float* scale; bf16_t* dst; int ldsrc, K, kt, nt, nsrc0, nvalid; };
__device__ __forceinline__ WtDesc wt_desc(const Params& p, int t) {
    WtDesc d; unsigned char* ws = p.ws;
    const int l = t / 3264; int r = t % 3264;
    if (r < 960) { d.kt = r / 60; d.nt = r % 60; d.src = p.w_in + (size_t)l * DM * 3600; d.ldsrc = 3600; d.scale = p.norm1_w + l * DM; d.dst = (bf16_t*)(ws + WS_WIN) + (size_t)l * NINP * DM; d.K = DM;
        const int n0 = d.nt * 64; if (n0 < 2048) { d.nsrc0 = n0; d.nvalid = 64; } else if (n0 < 3584) { d.nsrc0 = n0 + 16; d.nvalid = 64; } else if (n0 == 3584) { d.nsrc0 = 2048; d.nvalid = 16; } else { d.nsrc0 = 0; d.nvalid = 0; } }
    else if (r < 1216) { r -= 960; d.kt = r / 16; d.nt = r % 16; d.src = p.w_out + (size_t)l * DM * DM; d.ldsrc = DM; d.scale = nullptr; d.dst = (bf16_t*)(ws + WS_WOUT) + (size_t)l * DM * DM; d.K = DM; d.nsrc0 = d.nt * 64; d.nvalid = 64; }
    else if (r < 2240) { r -= 1216; d.kt = r / 64; d.nt = r % 64; d.src = p.w_ff1 + (size_t)l * DM * DFF; d.ldsrc = DFF; d.scale = p.norm2_w + l * DM; d.dst = (bf16_t*)(ws + WS_WFF1) + (size_t)l * DFF * DM; d.K = DM; d.nsrc0 = d.nt * 64; d.nvalid = 64; }
    else { r -= 2240; d.kt = r / 16; d.nt = r % 16; d.src = p.w_ff2 + (size_t)l * DFF * DM; d.ldsrc = DM; d.scale = nullptr; d.dst = (bf16_t*)(ws + WS_WFF2) + (size_t)l * DM * DFF; d.K = DFF; d.nsrc0 = d.nt * 64; d.nvalid = 64; }
    return d;
}
__device__ __forceinline__ void prep_phase(const Params& p, LAS unsigned char* lds, int lo, int hi, bool with_x) {
    const int tid = opaque_tid();
    unsigned char* ws = p.ws;
    constexpr int NT = 4;
    __syncthreads();
    for (int t = lo + blockIdx.x; t < hi; t += NT * gridDim.x) {
        WtDesc d[NT]; f32x4 v[NT][2]; float sc[NT][2]; bool has[NT];
#pragma unroll
        for (int q = 0; q < NT; ++q) { const int tq = t + q * gridDim.x; has[q] = tq < hi; d[q] = wt_desc(p, has[q] ? tq : t);
#pragma unroll
            for (int it = 0; it < 2; ++it) { const int kk = (tid >> 4) + 32 * it, n4 = (tid & 15) * 4;
                v[q][it] = (f32x4){0.f, 0.f, 0.f, 0.f};
                if (n4 < d[q].nvalid) v[q][it] = __builtin_nontemporal_load((const f32x4*)(d[q].src + (size_t)(d[q].kt * 64 + kk) * d[q].ldsrc + d[q].nsrc0 + n4));
                sc[q][it] = d[q].scale ? d[q].scale[d[q].kt * 64 + kk] : 1.0f; } }
#pragma unroll
        for (int q = 0; q < NT; ++q) { LAS float* T = (LAS float*)lds + q * 4160;
#pragma unroll
            for (int it = 0; it < 2; ++it) { const int kk = (tid >> 4) + 32 * it, n4 = (tid & 15) * 4;
#pragma unroll
                for (int e = 0; e < 4; ++e) T[(n4 + e) * 65 + kk] = v[q][it][e] * sc[q][it]; } }
        __syncthreads();
#pragma unroll
        for (int q = 0; q < NT; ++q) if (has[q]) { const LAS float* T = (const LAS float*)lds + q * 4160; const int n = tid >> 3, k8 = (tid & 7) * 8; float f[8];
#pragma unroll
            for (int e = 0; e < 8; ++e) f[e] = T[n * 65 + k8 + e];
            u32x4 w; w.x = cvt_pk_bf16(f[0], f[1]); w.y = cvt_pk_bf16(f[2], f[3]); w.z = cvt_pk_bf16(f[4], f[5]); w.w = cvt_pk_bf16(f[6], f[7]);
            *(u32x4*)(d[q].dst + (size_t)(d[q].nt * 64 + n) * d[q].K + d[q].kt * 64 + k8) = w; }
        __syncthreads();
    }
    if (!with_x) return;
    const int wave = tid >> 6, lane = tid & 63;
    bf16_t* XB = (bf16_t*)(ws + WS_XB); ssq_t* ssq = (ssq_t*)(ws + WS_SSQ);
    for (int t = blockIdx.x; t < MROWS / 16; t += gridDim.x) {
        f32x4 v[2][4];
#pragma unroll
        for (int q = 0; q < 2; ++q) { const f32x4* xr = (const f32x4*)(p.x + (size_t)(t * 16 + wave * 2 + q) * DM);
#pragma unroll
            for (int it = 0; it < 4; ++it) v[q][it] = __builtin_nontemporal_load(xr + it * 64 + lane); }
#pragma unroll
        for (int q = 0; q < 2; ++q) { const int row = t * 16 + wave * 2 + q; float s = 0.f;
#pragma unroll
            for (int it = 0; it < 4; ++it) { const f32x4 x = v[q][it]; s += (x[0] * x[0] + x[1] * x[1]) + (x[2] * x[2] + x[3] * x[3]);
                u32x2 w; w.x = cvt_pk_bf16(x[0], x[1]); w.y = cvt_pk_bf16(x[2], x[3]); *(u32x2*)(XB + (size_t)row * DM + (it * 64 + lane) * 4) = w; }
#pragma unroll
            for (int o = 32; o >= 1; o >>= 1) s += __shfl_xor(s, o);
            if (lane == 0) ssq[row] = ssq_enc(s); }
    }
    for (int i = blockIdx.x * 512 + tid; i < 4 * MROWS; i += gridDim.x * 512) ssq[MROWS + i] = 0u;
}

__device__ __forceinline__ void conv_phase(const Params& p, int l) {
    const int tid = opaque_tid(), cgp = tid & 127, rg = tid >> 7, c0 = cgp * 8;
    const bf16_t* PROJ = (const bf16_t*)(p.ws + WS_R1); bf16_t* QKC = (bf16_t*)(p.ws + WS_QKC);
    const float* cw = p.conv_w + (size_t)l * 3 * 1024; const float* cb = p.conv_b + (size_t)l * 1024;
    float w0[8], w1[8], w2[8], bb[8];
#pragma unroll
    for (int e = 0; e < 8; ++e) { w0[e] = cw[c0 + e]; w1[e] = cw[1024 + c0 + e]; w2[e] = cw[2048 + c0 + e]; bb[e] = cb[c0 + e]; }
    const float ksc = (c0 >= 512) ? 0.08838834764831845f : 1.0f;
    for (int t = blockIdx.x; t < MROWS / 16; t += gridDim.x) {
        const int r0 = t * 16 + rg * 4;
        u32x4 rw[6];
#pragma unroll
        for (int q = 0; q < 6; ++q) {
            const bool ok = !((q == 0 && (r0 & (SEQ - 1)) == 0) || (q == 5 && ((r0 + 3) & (SEQ - 1)) == SEQ - 1));
            rw[q] = (u32x4){0u, 0u, 0u, 0u};
            if (ok) rw[q] = *(const u32x4*)(PROJ + (size_t)(r0 - 1 + q) * NPROJ + c0);
        }
#pragma unroll
        for (int i = 0; i < 4; ++i) {
            float y[8];
#pragma unroll
            for (int e2 = 0; e2 < 4; ++e2) {
                const float a0 = bf_lo(rw[i][e2]), a1 = bf_hi(rw[i][e2]), b0 = bf_lo(rw[i + 1][e2]), b1 = bf_hi(rw[i + 1][e2]), c0f = bf_lo(rw[i + 2][e2]), c1f = bf_hi(rw[i + 2][e2]);
                y[2 * e2] = w0[2 * e2] * a0 + w1[2 * e2] * b0 + w2[2 * e2] * c0f + bb[2 * e2];
                y[2 * e2 + 1] = w0[2 * e2 + 1] * a1 + w1[2 * e2 + 1] * b1 + w2[2 * e2 + 1] * c1f + bb[2 * e2 + 1];
            }
#pragma unroll
            for (int e = 0; e < 8; ++e) y[e] = y[e] / (1.0f + __expf(-y[e])) * ksc;
            u32x4 w; w.x = cvt_pk_bf16(y[0], y[1]); w.y = cvt_pk_bf16(y[2], y[3]); w.z = cvt_pk_bf16(y[4], y[5]); w.w = cvt_pk_bf16(y[6], y[7]);
            *(u32x4*)(QKC + (size_t)(r0 + i) * DM + c0) = w;
        }
    }
}

constexpr int NA_VSTR = 144;
constexpr int NA_KR = 0, NA_VR = 8 * 64 * 128, NA_MRG = NA_VR + 8 * 64 * NA_VSTR, NA_BT = NA_MRG + 4 * 18 * 64 * 4, NA_END = NA_BT + 15 * 32 * 4;
static_assert(NA_END <= LDS_BYTES - 16, "NA LDS");
__device__ __forceinline__ void na_phase(const Params& p, int l, LAS unsigned char* lds, bool probe = false) {
    const int tid = opaque_tid(), w = __builtin_amdgcn_readfirstlane(tid >> 6), lane = tid & 63, g = lane >> 4, c = lane & 15;
    bf16_t* PROJ = (bf16_t*)(p.ws + WS_R1);
    const int half = w >> 2, qt = w & 3, c0 = qt * 16;
    const int wsn = (c0 - 8 < 0) ? 0 : ((c0 - 8 > 32) ? 32 : c0 - 8);
    const int qc = c0 + c;
    const int cs = (qc - 8 < 0) ? 0 : ((qc - 8 > 48) ? 48 : qc - 8);
    int rc[2][4];
#pragma unroll
    for (int kt = 0; kt < 2; ++kt)
#pragma unroll
        for (int i = 0; i < 4; ++i) { const int kc = wsn + kt * 16 + 4 * g + i; rc[kt][i] = ((kc >= cs) && (kc < cs + 16)) ? (kc - qc + 15) : 31; }
    const int skey = tid >> 3, sch = tid & 7;
    const int skoff = skey * 128 + ((sch ^ (skey & 7)) * 16), svoff = skey * NA_VSTR + sch * 16;
    LAS float* bt = (LAS float*)(lds + NA_BT);
    for (int task = blockIdx.x; task < 256; task += gridDim.x) {
        const int head = task & 7, strip = (task >> 3) & 3, b = task >> 5;
        const int r0 = strip * 16;
        const bf16_t* kvbase = PROJ + ((size_t)b * SEQ + skey) * NPROJ + 2560 + head * 64 + sch * 8;
        int rs = (r0 - 4 < 0) ? 0 : ((r0 - 4 > 56) ? 56 : r0 - 4);
        __syncthreads();
        { u32x4 kk8[8], vv8[8];
#pragma unroll
          for (int j = 0; j < 8; ++j) { const bf16_t* src = kvbase + (size_t)(rs + j) * 64 * NPROJ; kk8[j] = *(const u32x4*)src; vv8[j] = *(const u32x4*)(src + 512); }
#pragma unroll
          for (int j = 0; j < 8; ++j) { const int slot = (rs + j) & 7; *(LAS u32x4*)(lds + NA_KR + slot * 8192 + skoff) = kk8[j]; *(LAS u32x4*)(lds + NA_VR + slot * 9216 + svoff) = vv8[j]; } }
        if (tid < 480) { const int br_ = tid >> 5, bc_ = tid & 31; bt[tid] = (bc_ < 31) ? p.rpb[(size_t)l * 8 * 465 + (size_t)head * 465 + br_ * 31 + bc_] * 1.4426950408889634f : -1e30f; }
        bf16x8 qf[2];
        { const size_t qtok = (size_t)b * SEQ + (size_t)r0 * 64 + c0 + c;
#pragma unroll
          for (int kk = 0; kk < 2; ++kk) qf[kk] = *(const bf16x8*)(PROJ + qtok * NPROJ + 2048 + head * 64 + kk * 32 + g * 8); }
        LDS_BARRIER();
        float breg[4][2][4]; int boff = 0x7fffffff;
#pragma unroll 1
        for (int ri = 0; ri < 16; ++ri) {
            const int r = r0 + ri;
            if (rs - r != boff) { boff = rs - r;
#pragma unroll
                for (int j = 0; j < 4; ++j)
#pragma unroll
                    for (int kt = 0; kt < 2; ++kt)
#pragma unroll
                        for (int i = 0; i < 4; ++i) breg[j][kt][i] = bt[(boff + 4 * half + j + 7) * 32 + rc[kt][i]]; }
            const size_t qtok = (size_t)b * SEQ + (size_t)r * 64 + c0 + c;
            const int rn = (ri < 15) ? r + 1 : r;
            const int rsn = (rn - 4 < 0) ? 0 : ((rn - 4 > 56) ? 56 : rn - 4);
            const bool slide = rsn != rs;
            const bf16_t* nsrc = kvbase + (size_t)(rsn + 7) * 64 * NPROJ;
            const u32x4 nk = *(const u32x4*)nsrc, nv = *(const u32x4*)(nsrc + 512);
            bf16x8 qfn[2];
            { const size_t qtokn = (size_t)b * SEQ + (size_t)rn * 64 + c0 + c;
#pragma unroll
              for (int kk = 0; kk < 2; ++kk) qfn[kk] = *(const bf16x8*)(PROJ + qtokn * NPROJ + 2048 + head * 64 + kk * 32 + g * 8); }
            __builtin_amdgcn_sched_barrier(0);
            f32x4 sc[4][2];
#pragma unroll
            for (int j = 0; j < 4; ++j) { const int slot = (rs + 4 * half + j) & 7;
#pragma unroll
                for (int kt = 0; kt < 2; ++kt) { f32x4 a = (f32x4){0.f, 0.f, 0.f, 0.f}; const int key = wsn + kt * 16 + c;
#pragma unroll
                    for (int kk = 0; kk < 2; ++kk) { const bf16x8 kfr = *(const LAS bf16x8*)(lds + NA_KR + slot * 8192 + key * 128 + (((kk * 4 + g) ^ (key & 7)) * 16)); a = mfma16(kfr, qf[kk], a); }
                    sc[j][kt] = a; } }
            float mrun = -1e30f;
#pragma unroll
            for (int j = 0; j < 4; ++j) {
#pragma unroll
                for (int kt = 0; kt < 2; ++kt)
#pragma unroll
                    for (int i = 0; i < 4; ++i) { const float sv = sc[j][kt][i] * 0.18033688011112042f + breg[j][kt][i]; sc[j][kt][i] = sv; mrun = fmaxf(mrun, sv); } }
            mrun = fmaxf(mrun, __shfl_xor(mrun, 16)); mrun = fmaxf(mrun, __shfl_xor(mrun, 32));
            float lrun = 0.f;
#pragma unroll
            for (int j = 0; j < 4; ++j)
#pragma unroll
                for (int kt = 0; kt < 2; ++kt)
#pragma unroll
                    for (int i = 0; i < 4; ++i) { const float pv = __builtin_amdgcn_exp2f(sc[j][kt][i] - mrun); sc[j][kt][i] = pv; lrun += pv; }
            lrun += __shfl_xor(lrun, 16); lrun += __shfl_xor(lrun, 32);
            f32x4 O[4];
#pragma unroll
            for (int dt = 0; dt < 4; ++dt) O[dt] = (f32x4){0.f, 0.f, 0.f, 0.f};
#pragma unroll
            for (int j = 0; j < 4; ++j) { const int slot = (rs + 4 * half + j) & 7;
                u32x4 pw; pw.x = cvt_pk_bf16(sc[j][0][0], sc[j][0][1]); pw.y = cvt_pk_bf16(sc[j][0][2], sc[j][0][3]); pw.z = cvt_pk_bf16(sc[j][1][0], sc[j][1][1]); pw.w = cvt_pk_bf16(sc[j][1][2], sc[j][1][3]);
                const bf16x8 pf = __builtin_bit_cast(bf16x8, pw);
                LAS unsigned char* vb = lds + NA_VR + slot * 9216 + (wsn + 4 * g + (c >> 2)) * NA_VSTR + (c & 3) * 8;
#pragma unroll
                for (int dt = 0; dt < 4; ++dt) { const s16x4 t0 = tr_read(vb + dt * 32), t1 = tr_read(vb + 16 * NA_VSTR + dt * 32); O[dt] = mfma16(cat4(t0, t1), pf, O[dt]); }
            }
            LDS_BARRIER();
            LAS float* MRG = (LAS float*)(lds + NA_MRG) + qt * 18 * 64 + lane;
            if (half == 1) { MRG[0] = mrun; MRG[64] = lrun;
#pragma unroll
                for (int dt = 0; dt < 4; ++dt)
#pragma unroll
                    for (int i = 0; i < 4; ++i) MRG[(2 + dt * 4 + i) * 64] = O[dt][i]; }
            if (slide) { const int slot = (rsn + 7) & 7; *(LAS u32x4*)(lds + NA_KR + slot * 8192 + skoff) = nk; *(LAS u32x4*)(lds + NA_VR + slot * 9216 + svoff) = nv; }
            LDS_BARRIER();
            if (half == 0) {
                const float m1 = MRG[0], l1 = MRG[64];
                const float m = fmaxf(mrun, m1), a0 = __builtin_amdgcn_exp2f(mrun - m), a1 = __builtin_amdgcn_exp2f(m1 - m);
                const float inv = 1.0f / (lrun * a0 + l1 * a1);
#pragma unroll
                for (int dt = 0; dt < 4; ++dt) { f32x4 o;
#pragma unroll
                    for (int i = 0; i < 4; ++i) o[i] = (O[dt][i] * a0 + MRG[(2 + dt * 4 + i) * 64] * a1) * inv;
                    u32x2 wv; wv.x = cvt_pk_bf16(o[0], o[1]); wv.y = cvt_pk_bf16(o[2], o[3]);
                    if (probe) *(u32x2*)(PROJ + (size_t)MROWS * NPROJ + qtok * 512 + head * 64 + dt * 16 + 4 * g) = wv; else *(u32x2*)(PROJ + qtok * NPROJ + 2048 + head * 64 + dt * 16 + 4 * g) = wv; }
            }
            rs = rsn; qf[0] = qfn[0]; qf[1] = qfn[1];
        }
    }
    __syncthreads();
}

constexpr int ML_QSTR = 272, ML_VSTR = 112, ML_PSTR = 144, ML_SCB = 1536;
constexpr int ML_QS = 0, ML_KS = ML_QS + 2 * 64 * ML_QSTR, ML_VS = ML_KS + 2 * 64 * ML_QSTR, ML_VG = ML_VS + 2 * 64 * ML_VSTR, ML_PS = ML_VG + 2 * 64 * ML_VSTR,
              ML_CS = ML_PS + 2 * 64 * ML_PSTR, ML_SC = ML_CS + 2 * 48 * ML_QSTR, ML_END = ML_SC + 3 * ML_SCB;
static_assert(ML_END <= LDS_BYTES - 16, "mLSTM LDS");
#define ML_TOK(n, j) (tokb + (size_t)(dir ? (SEQ - 1 - ((n) * 64 + (j))) : ((n) * 64 + (j))))
__device__ __forceinline__ void mpre_phase(const Params& p, int l) {
    const int tid = opaque_tid(), w = tid >> 6, lane = tid & 63, g = lane >> 4, c = lane & 15;
    const bf16_t* QKC = (const bf16_t*)(p.ws + WS_QKC); const float* G = (const float*)(p.ws + WS_G); bf16_t* PBUF = (bf16_t*)(p.ws + WS_PBUF);
    for (int inst = blockIdx.x * 8 + w; inst < 4096; inst += gridDim.x * 8) {
        const int n = inst & 63, dir = (inst >> 6) & 1, h = (inst >> 7) & 3, b = inst >> 9;
        const size_t tokb = (size_t)b * SEQ;
        const size_t tk = ML_TOK(n, lane);
        const float ig = G[tk * 16 + (2 * dir) * 4 + h] + p.gate_b[l * 16 + (2 * dir) * 4 + h], fp = G[tk * 16 + (2 * dir + 1) * 4 + h] + p.gate_b[l * 16 + (2 * dir + 1) * 4 + h];
        bf16x8 kf[4][4], qf[4][4];
#pragma unroll
        for (int mt = 0; mt < 4; ++mt) { const size_t tkm = ML_TOK(n, 16 * mt + c);
#pragma unroll
            for (int kk = 0; kk < 4; ++kk) { kf[mt][kk] = *(const bf16x8*)(QKC + tkm * DM + 512 + h * 128 + kk * 32 + g * 8); qf[mt][kk] = *(const bf16x8*)(QKC + tkm * DM + h * 128 + kk * 32 + g * 8); } }
        float bcum = fminf(fp, 0.f) - __logf(1.0f + __expf(-fabsf(fp)));
#pragma unroll
        for (int o = 1; o < 64; o <<= 1) { const float t_ = __shfl_up(bcum, o); if (lane >= o) bcum += t_; }
        const float u = ig - bcum; float cm = u;
#pragma unroll
        for (int o = 1; o < 64; o <<= 1) { const float t_ = __shfl_up(cm, o); if (lane >= o) cm = fmaxf(cm, t_); }
        { float* sl = (float*)(p.ws + WS_SCAL) + (size_t)inst * 192; sl[lane] = bcum; sl[64 + lane] = u; sl[128 + lane] = cm; }
        bf16_t* pb = PBUF + (size_t)inst * 4096;
#pragma unroll
        for (int mt = 0; mt < 4; ++mt)
#pragma unroll
            for (int nt = 0; nt < 4; ++nt) { u32x2 pw = (u32x2){0u, 0u};
                if (mt <= nt) { f32x4 a = (f32x4){0.f, 0.f, 0.f, 0.f};
#pragma unroll
                    for (int kk = 0; kk < 4; ++kk) a = mfma16(kf[mt][kk], qf[nt][kk], a);
                    const float cmj = __shfl(cm, 16 * nt + c); float pv[4];
#pragma unroll
                    for (int i = 0; i < 4; ++i) { const int s_ = 16 * mt + 4 * g + i; const float us = __shfl(u, s_); pv[i] = (s_ <= 16 * nt + c) ? __expf(us - cmj) * a[i] : 0.f; }
                    pw.x = cvt_pk_bf16(pv[0], pv[1]); pw.y = cvt_pk_bf16(pv[2], pv[3]); }
                *(u32x2*)(pb + (16 * nt + c) * 64 + 16 * mt + 4 * g) = pw; }
    }
}

__device__ __forceinline__ void mlstm_phase(const Params& p, int l, LAS unsigned char* lds) {
    const int tid = opaque_tid(), w = __builtin_amdgcn_readfirstlane(tid >> 6), lane = tid & 63, g = lane >> 4, c = lane & 15;
    bf16_t* PROJ = (bf16_t*)(p.ws + WS_R1); const bf16_t* QKC = (const bf16_t*)(p.ws + WS_QKC); const float* G = (const float*)(p.ws + WS_G);
    const bf16_t* PBUF = (const bf16_t*)(p.ws + WS_PBUF);
    for (int task = blockIdx.x; task < 256; task += gridDim.x) {
        const int xq = task & 7, yq = task >> 3, vs = yq & 3, dir = (yq >> 2) & 1, bh = xq + 8 * (yq >> 3), h = bh & 3, b = bh >> 2;
        const size_t tokb = (size_t)b * SEQ;
        const bf16_t* pbase = PBUF + (size_t)(((b * 4 + h) * 2 + dir) * 64) * 4096 + (tid >> 3) * 64 + (tid & 7) * 8;
        const float gbi = p.gate_b[l * 16 + (2 * dir) * 4 + h], gbf = p.gate_b[l * 16 + (2 * dir + 1) * 4 + h];
        float mprev_chain = 0.f;
        __syncthreads();
        for (int i = tid; i < 48 * ML_QSTR / 4; i += 512) ((LAS unsigned*)(lds + ML_CS))[i] = 0u;
#define ML_GLOAD(n) do { const float* sl_ = scal + (size_t)(n) * 192; g_b = sl_[lane]; g_u = sl_[64 + lane]; g_cm = sl_[128 + lane]; } while (0)
#define ML_SCAN(sci) do { \
            const float Mj_ = fmaxf(mprev_chain, g_cm); \
            const float M63_ = __builtin_bit_cast(float, __builtin_amdgcn_readlane(__builtin_bit_cast(int, Mj_), 63)), tot_ = __builtin_bit_cast(float, __builtin_amdgcn_readlane(__builtin_bit_cast(int, g_b), 63)); \
            LAS float* sc_ = (LAS float*)(lds + ML_SC + (sci) * ML_SCB); \
            sc_[lane] = g_b; sc_[128 + lane] = Mj_; sc_[192 + lane] = __expf(g_u - M63_); sc_[320 + lane] = __expf(g_cm - Mj_); \
            if (lane == 0) { sc_[256] = __expf(mprev_chain - M63_); sc_[257] = mprev_chain; } \
            mprev_chain = tot_ + M63_; } while (0)
        const float* scal = (const float*)(p.ws + WS_SCAL) + (size_t)(((b * 4 + h) * 2 + dir) * 64) * 192;
        float g_b = 0.f, g_u = 0.f, g_cm = 0.f;
        if (w == 7) { ML_GLOAD(0); ML_SCAN(0); ML_GLOAD(1); ML_SCAN(1); }
        u32x4 qreg[1][2], kreg[1][2], vreg[1], preg[1];
        const long dtok = dir ? -1 : 1;
        const bf16_t* qp0 = QKC + ML_TOK(0, tid >> 4) * DM + h * 128 + (tid & 15) * 8;
        const bf16_t* vp = PROJ + ML_TOK(0, tid >> 2) * NPROJ + 1024 + h * 128 + vs * 32 + (tid & 3) * 8;
        const bf16_t* pp = pbase;
#define ML_LOAD(n, rs_) do { \
            qreg[rs_][0] = *(const u32x4*)(qp0); kreg[rs_][0] = *(const u32x4*)(qp0 + 512); \
            qreg[rs_][1] = *(const u32x4*)(qp0 + dtok * 32 * DM); kreg[rs_][1] = *(const u32x4*)(qp0 + dtok * 32 * DM + 512); \
            preg[rs_] = *(const u32x4*)(pp); \
            if (tid < 256) vreg[rs_] = *(const u32x4*)(vp); \
            qp0 += dtok * 64 * DM; vp += dtok * 64 * NPROJ; pp += 4096; } while (0)
#define ML_STORE(bufi, sci, rs_) do { \
            _Pragma("unroll") for (int it = 0; it < 2; ++it) { const int pc = it * 512 + tid, j = pc >> 4, part = pc & 15; \
                *(LAS u32x4*)(lds + ML_QS + (bufi) * 64 * ML_QSTR + j * ML_QSTR + part * 16) = qreg[rs_][it]; *(LAS u32x4*)(lds + ML_KS + (bufi) * 64 * ML_QSTR + j * ML_QSTR + part * 16) = kreg[rs_][it]; } \
            *(LAS u32x4*)(lds + ML_PS + (bufi) * 64 * ML_PSTR + (tid >> 3) * ML_PSTR + (tid & 7) * 16) = preg[rs_]; \
            const LAS float* scg_ = (const LAS float*)(lds + ML_SC + (sci) * ML_SCB + 192 * 4); \
            if (tid < 256) { const int j = tid >> 2, part = tid & 3; const float gj = scg_[j]; \
                *(LAS u32x4*)(lds + ML_VS + (bufi) * 64 * ML_VSTR + j * ML_VSTR + part * 16) = vreg[rs_]; u32x4 vg; \
                _Pragma("unroll") for (int e = 0; e < 4; ++e) vg[e] = cvt_pk_bf16(bf_lo(vreg[rs_][e]) * gj, bf_hi(vreg[rs_][e]) * gj); \
                *(LAS u32x4*)(lds + ML_VG + (bufi) * 64 * ML_VSTR + j * ML_VSTR + part * 16) = vg; } \
            else if (tid < 320) { const int j = tid - 256; const float gj = scg_[j]; \
                *(LAS u32x4*)(lds + ML_VS + (bufi) * 64 * ML_VSTR + j * ML_VSTR + 64) = (u32x4){0x3F80u, 0u, 0u, 0u}; *(LAS u32x4*)(lds + ML_VS + (bufi) * 64 * ML_VSTR + j * ML_VSTR + 80) = (u32x4){0u, 0u, 0u, 0u}; \
                *(LAS u32x4*)(lds + ML_VG + (bufi) * 64 * ML_VSTR + j * ML_VSTR + 64) = (u32x4){cvt_pk_bf16(gj, 0.f), 0u, 0u, 0u}; *(LAS u32x4*)(lds + ML_VG + (bufi) * 64 * ML_VSTR + j * ML_VSTR + 80) = (u32x4){0u, 0u, 0u, 0u}; } } while (0)
        ML_LOAD(0, 0);
        __syncthreads();
        ML_STORE(0, 0, 0);
        __syncthreads();
        f32x4 CT[2][3];
#pragma unroll
        for (int a = 0; a < 2; ++a)
#pragma unroll
            for (int v = 0; v < 3; ++v) CT[a][v] = (f32x4){0.f, 0.f, 0.f, 0.f};
        int s0 = 0, s1 = 1, s2 = 2;
        bf16_t* hp = PROJ + ML_TOK(0, 16 * (w & 3) + c) * NPROJ + dir * 512 + h * 128 + vs * 32 + 4 * g;
#define ML_STEP_BODY \
            LAS unsigned char* QS = lds + ML_QS + buf * 64 * ML_QSTR; LAS unsigned char* KS = lds + ML_KS + buf * 64 * ML_QSTR; \
            LAS unsigned char* VS = lds + ML_VS + buf * 64 * ML_VSTR; LAS unsigned char* VG = lds + ML_VG + buf * 64 * ML_VSTR; \
            LAS unsigned char* PS = lds + ML_PS + buf * 64 * ML_PSTR; LAS unsigned char* CS = lds + ML_CS + buf * 48 * ML_QSTR; LAS unsigned char* CSn = lds + ML_CS + nb * 48 * ML_QSTR; \
            const LAS float* sc = (const LAS float*)(lds + ML_SC + s0 * ML_SCB); \
            u32x2 hw[2] = {(u32x2){0u, 0u}, (u32x2){0u, 0u}}; \
            if (n + 1 < 64) ML_LOAD(n + 1, 0); \
            if (w == 7 && n + 2 < 64) ML_GLOAD(n + 2); \
            if (w < 4) { \
                const float mprev = sc[257]; \
                bf16x8 qa[4]; \
_Pragma("unroll") \
                for (int kk = 0; kk < 4; ++kk) qa[kk] = *(const LAS bf16x8*)(QS + (16 * w + c) * ML_QSTR + kk * 64 + g * 16); \
                bf16x8 pa[2]; \
_Pragma("unroll") \
                for (int kk = 0; kk < 2; ++kk) pa[kk] = *(const LAS bf16x8*)(PS + (16 * w + c) * ML_PSTR + kk * 64 + g * 16); \
                const int jj = 16 * w + c; const float Mj = sc[128 + jj]; \
                const float wi = __expf(mprev - Mj), em = __expf(-(sc[jj] + Mj)), rho = sc[320 + jj]; \
                f32x4 num[3]; \
_Pragma("unroll") \
                for (int vt = 0; vt < 3; ++vt) { f32x4 a = (f32x4){0.f, 0.f, 0.f, 0.f}, a2 = (f32x4){0.f, 0.f, 0.f, 0.f}; \
_Pragma("unroll") \
                    for (int kk = 0; kk < 4; ++kk) { const bf16x8 cf = *(const LAS bf16x8*)(CS + (16 * vt + c) * ML_QSTR + kk * 64 + g * 16); a = mfma16(cf, qa[kk], a); } \
_Pragma("unroll") \
                    for (int kk = 0; kk < 2; ++kk) { LAS unsigned char* vb = VS + (32 * kk + 8 * g + (c >> 2)) * ML_VSTR + vt * 32 + (c & 3) * 8; \
                        const s16x4 t0 = tr_read(vb), t1 = tr_read(vb + 4 * ML_VSTR); a2 = mfma16(cat4(t0, t1), pa[kk], a2); } \
                    num[vt] = a * wi + a2 * rho; } \
                const float den = __shfl(num[2][0], c); const float inv = 1.0f / fmaxf(fabsf(den), em); \
_Pragma("unroll") \
                for (int vt = 0; vt < 2; ++vt) { const f32x4 o = num[vt] * inv; hw[vt].x = cvt_pk_bf16(o[0], o[1]); hw[vt].y = cvt_pk_bf16(o[2], o[3]); } \
            } else { \
                const int ww = w - 4; const float decay = sc[256]; \
_Pragma("unroll") \
                for (int a = 0; a < 2; ++a) \
_Pragma("unroll") \
                    for (int v = 0; v < 3; ++v) CT[a][v] = CT[a][v] * decay; \
_Pragma("unroll") \
                for (int kk = 0; kk < 2; ++kk) { bf16x8 af[2], bfr[3]; \
_Pragma("unroll") \
                    for (int a = 0; a < 2; ++a) { LAS unsigned char* kb = KS + (32 * kk + 8 * g + (c >> 2)) * ML_QSTR + (2 * ww + a) * 32 + (c & 3) * 8; af[a] = cat4(tr_read(kb), tr_read(kb + 4 * ML_QSTR)); } \
_Pragma("unroll") \
                    for (int v = 0; v < 3; ++v) { LAS unsigned char* vb = VG + (32 * kk + 8 * g + (c >> 2)) * ML_VSTR + v * 32 + (c & 3) * 8; bfr[v] = cat4(tr_read(vb), tr_read(vb + 4 * ML_VSTR)); } \
_Pragma("unroll") \
                    for (int a = 0; a < 2; ++a) \
_Pragma("unroll") \
                        for (int v = 0; v < 3; ++v) CT[a][v] = mfma16(af[a], bfr[v], CT[a][v]); } \
_Pragma("unroll") \
                for (int a = 0; a < 2; ++a) \
_Pragma("unroll") \
                    for (int v = 0; v < 3; ++v) { u32x2 cw; cw.x = cvt_pk_bf16(CT[a][v][0], CT[a][v][1]); cw.y = cvt_pk_bf16(CT[a][v][2], CT[a][v][3]); \
                        *(LAS u32x2*)(CSn + (16 * v + c) * ML_QSTR + (16 * (2 * ww + a) + 4 * g) * 2) = cw; } \
                if (w == 7 && n + 2 < 64) { ML_SCAN(s2); } \
            } \
            if (n + 1 < 64) ML_STORE(nb, s1, 0); \
            if (w < 4) { *(u32x2*)(hp) = hw[0]; *(u32x2*)(hp + 16) = hw[1]; } \
            LDS_BARRIER(); \
            { const int t_ = s0; s0 = s1; s1 = s2; s2 = t_; } \
            hp += dtok * 64 * NPROJ;
#pragma unroll 1
        for (int n2 = 0; n2 < 64; n2 += 2) {
            { constexpr int buf = 0, nb = 1; const int n = n2; ML_STEP_BODY }
            { constexpr int buf = 1, nb = 0; const int n = n2 + 1; ML_STEP_BODY }
        }
#undef ML_STEP_BODY
#undef ML_SCAN
#undef ML_GLOAD
#undef ML_LOAD
#undef ML_STORE
    }
}
#undef ML_TOK

__device__ __forceinline__ void combine_phase(const Params& p, int l) {
    const int tid = opaque_tid(), wave = tid >> 6, lane = tid & 63, col = lane * 8;
    bf16_t* PROJ = (bf16_t*)(p.ws + WS_R1);
    float nw[8];
#pragma unroll
    for (int e = 0; e < 8; ++e) nw[e] = p.mnorm_w[l * 512 + col + e];
    for (int t32 = blockIdx.x; t32 < MROWS / 32; t32 += gridDim.x) {
        u32x4 hf[4], hb[4], ov[4];
#pragma unroll
        for (int q = 0; q < 4; ++q) { const bf16_t* base = PROJ + (size_t)(t32 * 32 + wave * 4 + q) * NPROJ;
            hf[q] = *(const u32x4*)(base + col); hb[q] = *(const u32x4*)(base + 512 + col); ov[q] = *(const u32x4*)(base + 1536 + col); }
#pragma unroll
        for (int q = 0; q < 4; ++q) {
            float hv[8], ss = 0.f;
#pragma unroll
            for (int e = 0; e < 4; ++e) { hv[2 * e] = bf_lo(hf[q][e]) + bf_lo(hb[q][e]); hv[2 * e + 1] = bf_hi(hf[q][e]) + bf_hi(hb[q][e]); ss += hv[2 * e] * hv[2 * e] + hv[2 * e + 1] * hv[2 * e + 1]; }
            ss += __shfl_xor(ss, 1); ss += __shfl_xor(ss, 2); ss += __shfl_xor(ss, 4); ss += __shfl_xor(ss, 8);
            const float rs = rsqrtf(ss * (1.0f / 128.0f) + EPS);
            float y[8];
#pragma unroll
            for (int e = 0; e < 4; ++e) { const float o0 = bf_lo(ov[q][e]), o1 = bf_hi(ov[q][e]);
                y[2 * e] = hv[2 * e] * rs * nw[2 * e] / (1.0f + __expf(-o0)); y[2 * e + 1] = hv[2 * e + 1] * rs * nw[2 * e + 1] / (1.0f + __expf(-o1)); }
            u32x4 wv; wv.x = cvt_pk_bf16(y[0], y[1]); wv.y = cvt_pk_bf16(y[2], y[3]); wv.z = cvt_pk_bf16(y[4], y[5]); wv.w = cvt_pk_bf16(y[6], y[7]);
            *(u32x4*)(PROJ + (size_t)(t32 * 32 + wave * 4 + q) * NPROJ + 1536 + col) = wv;
        }
    }
}

__device__ __forceinline__ void final_phase(const Params& p) {
    const int tid = opaque_tid(); const ssq_t* ssq = (const ssq_t*)(p.ws + WS_SSQ) + 4 * MROWS; const bf16_t* XB = (const bf16_t*)(p.ws + WS_XB);
    const int c8 = (tid & 127) * 8;
    const f32x4 fw0 = *(const f32x4*)(p.fnorm_w + c8), fw1 = *(const f32x4*)(p.fnorm_w + c8 + 4);
    for (int r16 = blockIdx.x; r16 < MROWS / 16; r16 += gridDim.x) {
        u32x4 v[4]; float rs[4];
#pragma unroll
        for (int q = 0; q < 4; ++q) { const int row = r16 * 16 + q * 4 + (tid >> 7); v[q] = *(const u32x4*)(XB + (size_t)row * DM + c8); rs[q] = ssq_dec(ssq[row]); }
#pragma unroll
        for (int q = 0; q < 4; ++q) { const int row = r16 * 16 + q * 4 + (tid >> 7); const float r_ = rsqrtf(rs[q] * (1.0f / DM) + EPS);
            const f32x4 a = (f32x4){bf_lo(v[q].x), bf_hi(v[q].x), bf_lo(v[q].y), bf_hi(v[q].y)}, b = (f32x4){bf_lo(v[q].z), bf_hi(v[q].z), bf_lo(v[q].w), bf_hi(v[q].w)};
            float* op = p.out + (size_t)row * DM + c8;
            *(f32x4*)op = a * r_ * fw0; *(f32x4*)(op + 4) = b * r_ * fw1; }
    }
}

__device__ __forceinline__ void gates_phase(const Params& p, int l, const ssq_t* ssq) {
    const int tid = opaque_tid(), w = tid >> 6, lane = tid & 63, g = lane >> 4, c = lane & 15;
    const bf16_t* XB = (const bf16_t*)(p.ws + WS_XB); const bf16_t* Wg = (const bf16_t*)(p.ws + WS_WIN) + (size_t)l * NINP * DM + (size_t)NPROJ * DM;
    float* G = (float*)(p.ws + WS_G);
    for (int rb = blockIdx.x; rb < MROWS / 128; rb += gridDim.x) {
        const int row0 = rb * 128 + w * 16;
        const bf16_t* ap = XB + (size_t)(row0 + c) * DM + g * 8; const bf16_t* bp = Wg + (size_t)c * DM + g * 8;
        f32x4 acc = (f32x4){0.f, 0.f, 0.f, 0.f};
#pragma unroll 16
        for (int kk = 0; kk < 32; ++kk) { const bf16x8 a = *(const bf16x8*)(ap + kk * 32), b = *(const bf16x8*)(bp + kk * 32); acc = mfma16(a, b, acc); }
#pragma unroll
        for (int i = 0; i < 4; ++i) { const int row = row0 + 4 * g + i; G[(size_t)row * 16 + c] = acc[i] * rsqrtf(ssq_dec(ssq[row]) * (1.0f / DM) + EPS); }
    }
}

__global__ void __launch_bounds__(512, 2) fwd_kernel(Params p) {
    extern __shared__ __attribute__((aligned(16))) unsigned char smem[];
    LAS unsigned char* lds = (LAS unsigned char*)smem;
    unsigned char* ws = p.ws;
    bf16_t* XB = (bf16_t*)(ws + WS_XB); bf16_t* R1 = (bf16_t*)(ws + WS_R1); float* G = (float*)(ws + WS_G); ssq_t* ssq = (ssq_t*)(ws + WS_SSQ);
    volatile LAS unsigned* xst = (volatile LAS unsigned*)(lds + LDS_BYTES - 16);
    if (threadIdx.x < 4) xst[threadIdx.x] = 0u;
    __syncthreads();
    XcdBarrier xbar = xcd_barrier_post((unsigned*)(ws + WS_BAR), xst);
    for (int ph = p.ph_lo; ph < p.ph_hi; ++ph) {
        if (ph == 0) { prep_phase(p, lds, 0, 960, true); }
        else if (ph == 15) { if (PH_ON(8)) final_phase(p); }
        else {
            const int l = (ph - 1) / 7, sub = (ph - 1) % 7;
            pg8::StaticOrder S;
            if (sub == 0) { if (PH_ON(1)) {
                pg8::Gemm g; g.A = XB; g.Bt = (const bf16_t*)(ws + WS_WIN) + (size_t)l * NINP * DM; g.M = MROWS; g.N = NPROJ; g.K = DM; g.lda = DM;
                S.init(MROWS, NPROJ, gridDim.x, blockIdx.x);
                pg8::EpiProj E; E.P = R1; E.G = G; E.ssq = ssq + (size_t)(2 * l) * MROWS;
                pg8::gemm_phase(lds, g, S, E);
                if (REP(1)) pg8::gemm_phase(lds, g, S, E);
                gates_phase(p, l, E.ssq); }
            } else if (sub == 1) {
                { const int na_first = (blockIdx.x >> 3) & 1;
#pragma unroll 1
                  for (int pass = 0; pass < 2; ++pass) { if ((pass ^ na_first) == 1) na_phase(p, l, lds); else { conv_phase(p, l); if (l == 0) prep_phase(p, lds, 960, 6528, false); } } }
            } else if (sub == 2) {
                if (PH_ON(4)) { mpre_phase(p, l); xcd_barrier(xbar); mlstm_phase(p, l, lds); }
                if (REP(4)) mlstm_phase(p, l, lds);
            } else if (sub == 3) {
                if (PH_ON(5)) combine_phase(p, l);
            } else if (sub == 4) { if (PH_ON(6)) {
                pg8::Gemm g; g.A = R1 + 1536; g.Bt = (const bf16_t*)(ws + WS_WOUT) + (size_t)l * DM * DM; g.M = MROWS; g.N = DM; g.K = DM; g.lda = NPROJ;
                S.init(MROWS, DM, gridDim.x, blockIdx.x);
                pg8::EpiResid E; E.XinF = (l == 0) ? p.x : nullptr; E.XinB = XB; E.XoutF = nullptr; E.XB = XB; E.ssq = ssq + (size_t)(2 * l + 1) * MROWS;
                pg8::gemm_phase(lds, g, S, E); }
            } else if (sub == 5) { if (PH_ON(7)) {
                pg8::Gemm g; g.A = XB; g.Bt = (const bf16_t*)(ws + WS_WFF1) + (size_t)l * DFF * DM; g.M = MROWS; g.N = DFF; g.K = DM; g.lda = DM;
                S.init(MROWS, DFF, gridDim.x, blockIdx.x);
                pg8::EpiFF1 E; E.H = R1; E.ssq = ssq + (size_t)(2 * l + 1) * MROWS;
                pg8::gemm_phase(lds, g, S, E);
                if (REP(7)) pg8::gemm_phase(lds, g, S, E); }
            } else { if (PH_ON(9)) {
                pg8::Gemm g; g.A = R1; g.Bt = (const bf16_t*)(ws + WS_WFF2) + (size_t)l * DM * DFF; g.M = MROWS; g.N = DM; g.K = DFF; g.lda = HLD;
                S.init(MROWS, DM, gridDim.x, blockIdx.x);
                pg8::EpiResid E; E.XinF = nullptr; E.XinB = XB; E.XoutF = nullptr; E.XB = XB; E.ssq = ssq + (size_t)(2 * l + 2) * MROWS;
                pg8::gemm_phase(lds, g, S, E); }
            }
        }
        if (ph + 1 < p.ph_hi) { if (p.ph_lo < 0) cg::this_grid().sync(); else xcd_barrier(xbar); }
        if (REP(10) && ph == 3) { for (int q = 0; q < 10; ++q) xcd_barrier(xbar); }
    }
}

extern "C" void kernel_launch(void* const* d_in, const int* in_sizes, int n_in, void* d_out, int out_size, void* d_ws, size_t ws_size, hipStream_t stream) {
    static int grid = 0;
    if (grid == 0) {
        int dev = 0, cus = 0, per_cu = 0;
        (void)hipGetDevice(&dev);
        (void)hipDeviceGetAttribute(&cus, hipDeviceAttributeMultiprocessorCount, dev);
        if (hipFuncSetAttribute((const void*)fwd_kernel, hipFuncAttributeMaxDynamicSharedMemorySize, LDS_BYTES) != hipSuccess) fprintf(stderr, "hipFuncSetAttribute failed\n");
        (void)hipOccupancyMaxActiveBlocksPerMultiprocessor(&per_cu, (const void*)fwd_kernel, 512, LDS_BYTES);
        if (per_cu < 1) { fprintf(stderr, "occupancy query says %d blocks per CU\n", per_cu); per_cu = 1; }
        grid = cus * per_cu;
        if (ws_size < WS_END) fprintf(stderr, "workspace too small: %zu < %zu\n", ws_size, (size_t)WS_END);
    }
    Params p{};
    p.x = (const float*)d_in[0]; p.norm1_w = (const float*)d_in[1]; p.w_in = (const float*)d_in[2]; p.conv_w = (const float*)d_in[3]; p.conv_b = (const float*)d_in[4];
    p.gate_b = (const float*)d_in[5]; p.mnorm_w = (const float*)d_in[6]; p.rpb = (const float*)d_in[7]; p.w_out = (const float*)d_in[8]; p.norm2_w = (const float*)d_in[9];
    p.w_ff1 = (const float*)d_in[10]; p.w_ff2 = (const float*)d_in[11]; p.fnorm_w = (const float*)d_in[12];
    p.out = (float*)d_out; p.ws = (unsigned char*)d_ws;
    (void)hipMemsetAsync((unsigned char*)d_ws + WS_BAR, 0, 16384, stream);
#if MULTI_LAUNCH
    for (int ph = 0; ph < 16; ++ph) { p.ph_lo = ph; p.ph_hi = ph + 1; hipLaunchKernelGGL(fwd_kernel, dim3(grid), dim3(512), LDS_BYTES, stream, p); }
#else
    p.ph_lo = 0; p.ph_hi = 16;
    void* args[] = {&p};
    hipError_t e = hipLaunchCooperativeKernel((const void*)fwd_kernel, dim3(grid), dim3(512), args, LDS_BYTES, stream);
    if (e != hipSuccess) fprintf(stderr, "cooperative launch failed: %s (grid %d)\n", hipGetErrorString(e), grid);
#endif
}
```

```cpp
#include <hip/hip_runtime.h>
#include <hip/hip_cooperative_groups.h>
#include <cstdio>
namespace cg = cooperative_groups;

#ifndef MULTI_LAUNCH
#define MULTI_LAUNCH 0
#endif
#ifndef PHASE_MASK
#define PHASE_MASK 0xffff
#endif
#define PH_ON(k) ((PHASE_MASK >> (k)) & 1)
#ifndef REPEAT_MASK
#define REPEAT_MASK 0
#endif
#define REP(k) ((REPEAT_MASK >> (k)) & 1)

#define LAS __attribute__((address_space(3)))
typedef unsigned short bf16_t;
typedef short bf16x8 __attribute__((ext_vector_type(8)));
typedef short s16x4 __attribute__((ext_vector_type(4)));
typedef float f32x4 __attribute__((ext_vector_type(4)));
typedef unsigned u32x4 __attribute__((ext_vector_type(4)));
typedef unsigned u32x2 __attribute__((ext_vector_type(2)));
typedef unsigned ssq_t;
__device__ __forceinline__ ssq_t ssq_enc(float s) { return (ssq_t)(s * 1024.0f + 0.5f); }
__device__ __forceinline__ float ssq_dec(ssq_t v) { return (float)v * (1.0f / 1024.0f); }

constexpr int MROWS = 32768, DM = 1024, SEQ = 4096, NPROJ = 3584, NINP = 3840, DFF = 4096, HLD = 4160;
constexpr int LDS_BYTES = 163840;
constexpr float EPS = 1e-6f;

constexpr size_t WS_WIN = 0;
constexpr size_t WS_WOUT = WS_WIN + (size_t)2 * NINP * DM * 2;
constexpr size_t WS_WFF1 = WS_WOUT + (size_t)2 * DM * DM * 2;
constexpr size_t WS_WFF2 = WS_WFF1 + (size_t)2 * DFF * DM * 2;
constexpr size_t WS_XB = WS_WFF2 + (size_t)2 * DM * DFF * 2;
constexpr size_t WS_G = WS_XB + (size_t)MROWS * DM * 2;
constexpr size_t WS_SSQ = WS_G + (size_t)MROWS * 16 * 4;
constexpr size_t WS_R1 = WS_SSQ + (size_t)5 * MROWS * 8;
constexpr size_t WS_BAR = WS_R1 + (size_t)MROWS * HLD * 2;
constexpr size_t WS_PBUF = WS_BAR + 16384;
constexpr size_t WS_SCAL = WS_PBUF + (size_t)4096 * 8192;
constexpr size_t WS_QKC = WS_SCAL + (size_t)4096 * 192 * 4;
constexpr size_t WS_END = WS_QKC + (size_t)MROWS * DM * 2;

struct Params {
    const float* x; const float* norm1_w; const float* w_in; const float* conv_w; const float* conv_b; const float* gate_b;
    const float* mnorm_w; const float* rpb; const float* w_out; const float* norm2_w; const float* w_ff1; const float* w_ff2; const float* fnorm_w;
    float* out; unsigned char* ws; int ph_lo, ph_hi;
};

typedef __bf16 bf16x2_t __attribute__((ext_vector_type(2)));
__device__ __forceinline__ unsigned cvt_pk_bf16(float lo, float hi) { bf16x2_t v; v[0] = (__bf16)lo; v[1] = (__bf16)hi; return __builtin_bit_cast(unsigned, v); }
__device__ __forceinline__ int opaque_tid() { int t = threadIdx.x; asm volatile("" : "+v"(t)); return t; }
__device__ __forceinline__ float bf_lo(unsigned w) { return __uint_as_float(w << 16); }
__device__ __forceinline__ float bf_hi(unsigned w) { return __uint_as_float(w & 0xffff0000u); }
__device__ __forceinline__ s16x4 tr_read(LAS unsigned char* p) { return __builtin_amdgcn_ds_read_tr16_b64_v4i16((LAS s16x4*)p); }
__device__ __forceinline__ bf16x8 cat4(s16x4 a, s16x4 b) { bf16x8 r; r[0] = a[0]; r[1] = a[1]; r[2] = a[2]; r[3] = a[3]; r[4] = b[0]; r[5] = b[1]; r[6] = b[2]; r[7] = b[3]; return r; }
#define LDS_BARRIER() do { asm volatile("s_waitcnt lgkmcnt(0)" ::: "memory"); __builtin_amdgcn_s_barrier(); asm volatile("" ::: "memory"); } while (0)
__device__ __forceinline__ f32x4 mfma16(bf16x8 a, bf16x8 b, f32x4 c) { return __builtin_amdgcn_mfma_f32_16x16x32_bf16(a, b, c, 0, 0, 0); }


#define XB_TMO      128
#define XB_XCNT(j)  (256  + 64 * (j))
#define XB_XSUB(j)  (1280 + 64 * (j))
#define XB_XGEN(j)  (2304 + 64 * (j))
#define XB_TOP      3328
#define XB_TOPGEN   3392
#define XCD_BAR_WORDS 3456
#define XB_SPIN_CAP (1u << 22)
__device__ __forceinline__ unsigned xb_ld(unsigned* p)              { return __hip_atomic_load(p, __ATOMIC_RELAXED, __HIP_MEMORY_SCOPE_AGENT); }
__device__ __forceinline__ unsigned xb_add(unsigned* p, unsigned v) { return __hip_atomic_fetch_add(p, v, __ATOMIC_RELAXED, __HIP_MEMORY_SCOPE_AGENT); }
__device__ __forceinline__ unsigned xb_xcc_id() { return (unsigned)__builtin_amdgcn_s_getreg((3 << 11) | 20) & 0xFu; }
#define XB_SPIN(cond, bar) do { unsigned _sp = 0; while (cond) { __builtin_amdgcn_s_sleep(1); \
    if ((++_sp & 255u) == 0u) { if (xb_ld(&(bar)[XB_TMO])) break; if (_sp > XB_SPIN_CAP) { atomicAdd(&(bar)[XB_TMO], 1u); break; } } } } while (0)
struct XcdBarrier { unsigned* bar; unsigned x; volatile LAS unsigned* st; };
__device__ __forceinline__ XcdBarrier xcd_barrier_post(unsigned* bar, volatile LAS unsigned* st) {
    XcdBarrier b; b.bar = bar; b.x = xb_xcc_id(); b.st = st;
    if (threadIdx.x == 0) (void)xb_add(&bar[XB_XCNT(b.x)], 1u);
    return b;
}
__device__ __forceinline__ void xcd_barrier_complete(unsigned* bar, unsigned x, unsigned& nloc, unsigned& nx) {
    const unsigned G = gridDim.x * gridDim.y * gridDim.z;
    unsigned sum, cnt, mine, sp = 0u;
    for (;;) {
        sum = 0u; cnt = 0u; mine = 0u;
#pragma unroll
        for (unsigned j = 0; j < 16; ++j) { const unsigned c = xb_ld(&bar[XB_XCNT(j)]); sum += c; cnt += (c > 0u) ? 1u : 0u; mine = (j == x) ? c : mine; }
        if (sum == G) break;
        __builtin_amdgcn_s_sleep(1);
        if ((++sp & 255u) == 0u) { if (xb_ld(&bar[XB_TMO])) break; if (sp > XB_SPIN_CAP) { atomicAdd(&bar[XB_TMO], 1u); break; } }
    }
    nloc = mine > 0u ? mine : 1u; nx = cnt > 0u ? cnt : 1u;
}
__device__ __forceinline__ void xcd_barrier(const XcdBarrier& b) {
    asm volatile("s_waitcnt vmcnt(0)" ::: "memory");
    __syncthreads();
    if (threadIdx.x == 0) {
        unsigned* bar = b.bar;
        __builtin_amdgcn_s_waitcnt(0);
        unsigned nloc = b.st[0], nx = b.st[1];
        if (nloc == 0u) { xcd_barrier_complete(bar, b.x, nloc, nx); b.st[0] = nloc; b.st[1] = nx; }
        const unsigned old = xb_add(&bar[XB_XSUB(b.x)], 1u);
        const unsigned gen = old / nloc;
        if (old + 1u == (gen + 1u) * nloc) {
            __builtin_amdgcn_fence(__ATOMIC_RELEASE, "agent");
            asm volatile("s_waitcnt vmcnt(0)" ::: "memory");
            const unsigned og = xb_add(&bar[XB_TOP], 1u);
            const unsigned tg = og / nx;
            if (og + 1u == (tg + 1u) * nx) xb_add(&bar[XB_TOPGEN], 1u);
            else XB_SPIN(xb_ld(&bar[XB_TOPGEN]) == tg, bar);
            __builtin_amdgcn_fence(__ATOMIC_ACQUIRE, "agent");
            xb_add(&bar[XB_XGEN(b.x)], 1u);
            asm volatile("s_waitcnt vmcnt(0)" ::: "memory");
        } else {
            XB_SPIN(xb_ld(&bar[XB_XGEN(b.x)]) == gen, bar);
            __builtin_amdgcn_fence(__ATOMIC_ACQUIRE, "agent");
            asm volatile("s_waitcnt vmcnt(0)" ::: "memory");
        }
    }
    __syncthreads();
}

namespace pg8 {
constexpr int BM = 256, BK = 64, HALF = 128, HTB = HALF * BK * 2, STAGE_BYTES = 8 * HTB, NXCD = 8, WGM = 8;
__device__ __forceinline__ int lds_byte(int r, int c) { const int st = (r >> 4) * 2 + (c >> 5), rr = r & 15, cc = c & 31, ob = rr * 64 + cc * 2; return st * 1024 + (ob ^ (((ob >> 9) & 1) << 5)); }
__device__ __forceinline__ void stage_rc(int b, int& R, int& C) { const int st = b / 1024, sb = b % 1024, swz = sb ^ (((sb >> 9) & 1) << 5); R = (st >> 1) * 16 + swz / 64; C = (st & 1) * 32 + (swz % 64) / 2; }
__device__ __forceinline__ int perm32(int rho) { const int n = rho >> 4, i = rho & 15; return 8 * (i >> 2) + 4 * n + (i & 3); }
struct Unit { int pm, pn; };
struct Gemm { const bf16_t* A; const bf16_t* Bt; int M, N, K, lda; };
struct StaticOrder {
    int nM, nN, nwg, G, c;
    __device__ void init(int M, int N, int G_, int c_) { nM = M / BM; nN = N / BM; nwg = nM * nN; G = G_; c = c_; }
    __device__ bool next(int i, Unit& u) const {
        const long L = (long)i * G + c; if (L >= nwg) return false;
        int wgid = (int)L; { const int q = nwg / NXCD, r = nwg % NXCD, xcd = wgid % NXCD, off = wgid / NXCD; wgid = (xcd < r ? xcd * (q + 1) : r * (q + 1) + (xcd - r) * q) + off; }
        const int nig = WGM * nN, gid = wgid / nig, fm = gid * WGM, gsz = (nM - fm) < WGM ? (nM - fm) : WGM;
        u.pm = fm + ((wgid % nig) % gsz); u.pn = (wgid % nig) / gsz; return true;
    }
};

struct EpiProj {
    bf16_t* P; float* G; const ssq_t* ssq;
    static constexpr bool HAS_PRE = true;
    __device__ __forceinline__ void pre(const Unit& u, int wr, int fr, ssq_t (&pv)[8]) const {
        const int row0 = u.pm * BM + wr * 64 + fr;
#pragma unroll
        for (int ai = 0; ai < 2; ++ai)
#pragma unroll
            for (int m = 0; m < 4; ++m) pv[ai * 4 + m] = ssq[row0 + ai * HALF + m * 16];
    }
    __device__ __forceinline__ void operator()(const f32x4 (&acc)[2][2][4][2], const Unit& u, int wr, int wc, int fr, int fq, const ssq_t (&pv)[8]) const {
        const int row0 = u.pm * BM + wr * 64 + fr;
#pragma unroll
        for (int ai = 0; ai < 2; ++ai)
#pragma unroll
            for (int m = 0; m < 4; ++m) {
                const int row = row0 + ai * HALF + m * 16;
                const float rs = rsqrtf(ssq_dec(pv[ai * 4 + m]) * (1.0f / DM) + EPS);
                bf16_t* rowp = P + (size_t)row * NPROJ + u.pn * BM + wc * 32 + 8 * fq;
#pragma unroll
                for (int bj = 0; bj < 2; ++bj) { const f32x4 v0 = acc[ai][bj][m][0] * rs, v1 = acc[ai][bj][m][1] * rs;
                    u32x4 w; w.x = cvt_pk_bf16(v0[0], v0[1]); w.y = cvt_pk_bf16(v0[2], v0[3]); w.z = cvt_pk_bf16(v1[0], v1[1]); w.w = cvt_pk_bf16(v1[2], v1[3]);
                    *(u32x4*)(rowp + bj * HALF) = w; }
            }
    }
};
struct EpiResid { static constexpr bool INPLACE = true;
    const float* XinF; const bf16_t* XinB; float* XoutF; bf16_t* XB; ssq_t* ssq;
    static constexpr bool HAS_PRE = false;
    __device__ __forceinline__ void pre(const Unit&, int, int, ssq_t (&)[8]) const {}
    __device__ __forceinline__ void operator()(const f32x4 (&acc)[2][2][4][2], const Unit& u, int wr, int wc, int fr, int fq, const ssq_t (&)[8]) const {
        const int row0 = u.pm * BM + wr * 64 + fr, col0 = u.pn * BM + wc * 32 + 8 * fq;
#pragma unroll
        for (int ai = 0; ai < 2; ++ai) {
            f32x4 xo[4][2][2];
            if (XinF) {
#pragma unroll
                for (int m = 0; m < 4; ++m)
#pragma unroll
                    for (int bj = 0; bj < 2; ++bj) { const size_t off = (size_t)(row0 + ai * HALF + m * 16) * DM + col0 + bj * HALF; xo[m][bj][0] = *(const f32x4*)(XinF + off); xo[m][bj][1] = *(const f32x4*)(XinF + off + 4); }
            } else {
                u32x4 xb[4][2];
#pragma unroll
                for (int m = 0; m < 4; ++m)
#pragma unroll
                    for (int bj = 0; bj < 2; ++bj) xb[m][bj] = *(const u32x4*)(XinB + (size_t)(row0 + ai * HALF + m * 16) * DM + col0 + bj * HALF);
#pragma unroll
                for (int m = 0; m < 4; ++m)
#pragma unroll
                    for (int bj = 0; bj < 2; ++bj) { const u32x4 t = xb[m][bj]; xo[m][bj][0] = (f32x4){bf_lo(t.x), bf_hi(t.x), bf_lo(t.y), bf_hi(t.y)}; xo[m][bj][1] = (f32x4){bf_lo(t.z), bf_hi(t.z), bf_lo(t.w), bf_hi(t.w)}; }
            }
#pragma unroll
            for (int m = 0; m < 4; ++m) {
                const int row = row0 + ai * HALF + m * 16; float s = 0.f;
#pragma unroll
                for (int bj = 0; bj < 2; ++bj) { const size_t off = (size_t)row * DM + col0 + bj * HALF;
                    const f32x4 v0 = xo[m][bj][0] + acc[ai][bj][m][0], v1 = xo[m][bj][1] + acc[ai][bj][m][1];
                    if (XoutF) { *(f32x4*)(XoutF + off) = v0; *(f32x4*)(XoutF + off + 4) = v1; }
                    if (XB) { u32x4 w; w.x = cvt_pk_bf16(v0[0], v0[1]); w.y = cvt_pk_bf16(v0[2], v0[3]); w.z = cvt_pk_bf16(v1[0], v1[1]); w.w = cvt_pk_bf16(v1[2], v1[3]);
                        *(u32x4*)(XB + off) = w; }
                    s += (v0[0] * v0[0] + v0[1] * v0[1]) + (v0[2] * v0[2] + v0[3] * v0[3]) + (v1[0] * v1[0] + v1[1] * v1[1]) + (v1[2] * v1[2] + v1[3] * v1[3]); }
                s += __shfl_xor(s, 16); s += __shfl_xor(s, 32);
                if (fq == 0) atomicAdd(ssq + row, ssq_enc(s));
            }
        }
    }
};
struct EpiFF1 {
    bf16_t* H; const ssq_t* ssq;
    static constexpr bool HAS_PRE = true;
    __device__ __forceinline__ void pre(const Unit& u, int wr, int fr, ssq_t (&pv)[8]) const {
        const int row0 = u.pm * BM + wr * 64 + fr;
#pragma unroll
        for (int ai = 0; ai < 2; ++ai)
#pragma unroll
            for (int m = 0; m < 4; ++m) pv[ai * 4 + m] = ssq[row0 + ai * HALF + m * 16];
    }
    __device__ __forceinline__ void operator()(const f32x4 (&acc)[2][2][4][2], const Unit& u, int wr, int wc, int fr, int fq, const ssq_t (&pv)[8]) const {
        const int row0 = u.pm * BM + wr * 64 + fr, col0 = u.pn * BM + wc * 32 + 8 * fq;
#pragma unroll
        for (int ai = 0; ai < 2; ++ai)
#pragma unroll
            for (int m = 0; m < 4; ++m) {
                const int row = row0 + ai * HALF + m * 16;
                const float rs = rsqrtf(ssq_dec(pv[ai * 4 + m]) * (1.0f / DM) + EPS);
                bf16_t* rowp = H + (size_t)row * HLD + col0;
#pragma unroll
                for (int bj = 0; bj < 2; ++bj) { f32x4 v0 = acc[ai][bj][m][0] * rs, v1 = acc[ai][bj][m][1] * rs;
#pragma unroll
                    for (int j = 0; j < 4; ++j) { const float a = fmaxf(v0[j], 0.f), b = fmaxf(v1[j], 0.f); v0[j] = a * a; v1[j] = b * b; }
                    u32x4 w; w.x = cvt_pk_bf16(v0[0], v0[1]); w.y = cvt_pk_bf16(v0[2], v0[3]); w.z = cvt_pk_bf16(v1[0], v1[1]); w.w = cvt_pk_bf16(v1[2], v1[3]);
                    *(u32x4*)(rowp + bj * HALF) = w; }
            }
    }
};

template <class Epi>
__device__ __forceinline__ void gemm_phase(LAS unsigned char* lds, const Gemm g, const StaticOrder& S, const Epi& E) {
    const int tid = opaque_tid(), wid = __builtin_amdgcn_readfirstlane(tid >> 6), lane = tid & 63, wr = wid >> 2, wc = wid & 3, fr = lane & 15, fq = lane >> 4;
    const int K = g.K, nt = K / BK, lda = g.lda;
    unsigned voffA[2], voffB[2];
#pragma unroll
    for (int i = 0; i < 2; ++i) { int R, C; stage_rc(tid * 16 + i * 8192, R, C); const int Rb = (R & ~31) + perm32(R & 31);
        voffA[i] = (unsigned)(R * lda + C) * 2u; voffB[i] = (unsigned)(Rb * K + C) * 2u; }
    const size_t kstep = (size_t)(BK * 2);
    const size_t hstepA = (size_t)HALF * lda * 2, hstepB = (size_t)HALF * K * 2;
    const size_t tstepA = 2 * hstepA, tstepB = 2 * hstepB;
    const unsigned ldsw = (unsigned)wid * 1024u;
    const int aoff = lds_byte(wr * 64 + fr, fq * 8), boff = lds_byte(wc * 32 + fr, fq * 8);
#define PG8_SA(b, h) (((b) * 2 + (h)) * HTB)
#define PG8_SB(b, h) ((4 + (b) * 2 + (h)) * HTB)
#define PG8_STAGE(bufoff, gbase, voff) do { _Pragma("unroll") for (int _i = 0; _i < 2; ++_i) \
        __builtin_amdgcn_global_load_lds((const unsigned*)((const char*)(gbase) + (voff)[_i]), (LAS unsigned*)(lds + (bufoff) + ldsw + _i * 8192), 16, 0, 0); } while (0)
#define PG8_LDA(dst, b, h) do { _Pragma("unroll") for (int m = 0; m < 4; ++m) _Pragma("unroll") for (int k = 0; k < 2; ++k) dst[m][k] = *(const LAS bf16x8*)(lds + PG8_SA(b, h) + aoff + m * 2048 + k * 1024); } while (0)
#define PG8_LDB(dst, b, h) do { _Pragma("unroll") for (int n = 0; n < 2; ++n) _Pragma("unroll") for (int k = 0; k < 2; ++k) dst[n][k] = *(const LAS bf16x8*)(lds + PG8_SB(b, h) + boff + n * 2048 + k * 1024); } while (0)
#define PG8_MMA(ai, bj, At, Bt) do { __builtin_amdgcn_s_setprio(1); _Pragma("unroll") for (int m = 0; m < 4; ++m) _Pragma("unroll") for (int n = 0; n < 2; ++n) _Pragma("unroll") for (int k = 0; k < 2; ++k) \
        acc[ai][bj][m][n] = __builtin_amdgcn_mfma_f32_16x16x32_bf16(Bt[n][k], At[m][k], acc[ai][bj][m][n], 0, 0, 0); __builtin_amdgcn_s_setprio(0); } while (0)
#define PG8_WAIT_V(n) asm volatile("s_waitcnt vmcnt(" #n ")" ::: "memory")
#define PG8_WAIT_L(n) asm volatile("s_waitcnt lgkmcnt(" #n ")" ::: "memory")
#define PG8_BAR __builtin_amdgcn_s_barrier()
#define PG8_SCHED __builtin_amdgcn_sched_barrier(0)
    Unit cur, nxt; int ui = 0;
    if (!S.next(0, cur)) return;
    f32x4 acc[2][2][4][2];
#pragma unroll
    for (int a = 0; a < 2; ++a)
#pragma unroll
        for (int b = 0; b < 2; ++b)
#pragma unroll
            for (int m = 0; m < 4; ++m)
#pragma unroll
                for (int n = 0; n < 2; ++n) acc[a][b][m][n] = (f32x4){0.f, 0.f, 0.f, 0.f};
    bf16x8 At[4][2], B0[2][2], B1[2][2];
    ssq_t pv[8] = {0u, 0u, 0u, 0u, 0u, 0u, 0u, 0u};
    const char* cA = (const char*)g.A + (size_t)cur.pm * tstepA; const char* cB = (const char*)g.Bt + (size_t)cur.pn * tstepB;
    PG8_STAGE(PG8_SB(0, 0), cB, voffB); PG8_STAGE(PG8_SA(0, 0), cA, voffA); PG8_STAGE(PG8_SB(0, 1), cB + hstepB, voffB); PG8_STAGE(PG8_SA(0, 1), cA + hstepA, voffA);
    if (wr == 1) PG8_BAR;
    PG8_WAIT_V(4); PG8_BAR;
    PG8_STAGE(PG8_SB(1, 0), cB + kstep, voffB); PG8_STAGE(PG8_SA(1, 0), cA + kstep, voffA); PG8_STAGE(PG8_SB(1, 1), cB + hstepB + kstep, voffB);
    PG8_WAIT_V(6); PG8_BAR;
    for (;;) {
        const bool has_next = S.next(ui + 1, nxt);
        const char* nA = has_next ? (const char*)g.A + (size_t)nxt.pm * tstepA : cA; const char* nB = has_next ? (const char*)g.Bt + (size_t)nxt.pn * tstepB : cB;
        for (int t = 0; t < nt; t += 2) {
            const bool last = (t == nt - 2);
            const char* a1 = cA + (size_t)(t + 1) * kstep;
            const char* a2 = last ? nA : cA + (size_t)(t + 2) * kstep; const char* b2 = last ? nB : cB + (size_t)(t + 2) * kstep;
            const char* a3 = a2 + kstep; const char* b3 = b2 + kstep;
            if (Epi::HAS_PRE && last) E.pre(cur, wr, fr, pv);
            PG8_LDB(B0, 0, 0); PG8_SCHED; PG8_LDA(At, 0, 0); PG8_STAGE(PG8_SA(1, 1), a1 + hstepA, voffA);
            PG8_WAIT_L(8); PG8_BAR; PG8_WAIT_L(0); PG8_MMA(0, 0, At, B0); PG8_BAR; PG8_SCHED;
            PG8_LDB(B1, 0, 1); PG8_STAGE(PG8_SB(0, 0), b2, voffB);
            PG8_BAR; PG8_WAIT_L(0); PG8_MMA(0, 1, At, B1); PG8_BAR;
            PG8_LDA(At, 0, 1); PG8_STAGE(PG8_SA(0, 0), a2, voffA);
            PG8_BAR; PG8_WAIT_L(0); PG8_MMA(1, 0, At, B0); PG8_BAR; PG8_SCHED;
            PG8_STAGE(PG8_SB(0, 1), b2 + hstepB, voffB);
            PG8_WAIT_V(6); PG8_BAR; PG8_MMA(1, 1, At, B1); PG8_BAR;
            PG8_LDB(B0, 1, 0); PG8_SCHED; PG8_LDA(At, 1, 0); PG8_STAGE(PG8_SA(0, 1), a2 + hstepA, voffA);
            PG8_WAIT_L(8); PG8_BAR; PG8_WAIT_L(0); PG8_MMA(0, 0, At, B0); PG8_BAR; PG8_SCHED;
            PG8_LDB(B1, 1, 1); PG8_STAGE(PG8_SB(1, 0), b3, voffB);
            PG8_BAR; PG8_WAIT_L(0); PG8_MMA(0, 1, At, B1); PG8_BAR;
            PG8_LDA(At, 1, 1); PG8_STAGE(PG8_SA(1, 0), a3, voffA);
            PG8_BAR; PG8_WAIT_L(0); PG8_MMA(1, 0, At, B0); PG8_BAR; PG8_SCHED;
            PG8_STAGE(PG8_SB(1, 1), b3 + hstepB, voffB);
            PG8_WAIT_V(6); PG8_BAR; PG8_MMA(1, 1, At, B1); PG8_BAR;
        }
        E(acc, cur, wr, wc, fr, fq, pv);
        if (!has_next) break;
#pragma unroll
        for (int a = 0; a < 2; ++a)
#pragma unroll
            for (int b = 0; b < 2; ++b)
#pragma unroll
                for (int m = 0; m < 4; ++m)
#pragma unroll
                    for (int n = 0; n < 2; ++n) acc[a][b][m][n] = (f32x4){0.f, 0.f, 0.f, 0.f};
        cur = nxt; cA = nA; cB = nB; ++ui;
    }
    PG8_WAIT_V(0);
    if (wr == 0) PG8_BAR;
    PG8_BAR;
#undef PG8_SA
#undef PG8_SB
#undef PG8_STAGE
#undef PG8_LDA
#undef PG8_LDB
#undef PG8_MMA
#undef PG8_WAIT_V
#undef PG8_WAIT_L
#undef PG8_BAR
#undef PG8_SCHED
}
}

struct WtDesc { const float* src; const float* scale; bf16_t* dst; int ldsrc, K, kt, nt, nsrc0, nvalid; };
__device__ __forceinline__ WtDesc wt_desc(const Params& p, int t) {
    WtDesc d; unsigned char* ws = p.ws;
    const int l = t / 3264; int r = t % 3264;
    if (r < 960) { d.kt = r / 60; d.nt = r % 60; d.src = p.w_in + (size_t)l * DM * 3600; d.ldsrc = 3600; d.scale = p.norm1_w + l * DM; d.dst = (bf16_t*)(ws + WS_WIN) + (size_t)l * NINP * DM; d.K = DM;
        const int n0 = d.nt * 64; if (n0 < 2048) { d.nsrc0 = n0; d.nvalid = 64; } else if (n0 < 3584) { d.nsrc0 = n0 + 16; d.nvalid = 64; } else if (n0 == 3584) { d.nsrc0 = 2048; d.nvalid = 16; } else { d.nsrc0 = 0; d.nvalid = 0; } }
    else if (r < 1216) { r -= 960; d.kt = r / 16; d.nt = r % 16; d.src = p.w_out + (size_t)l * DM * DM; d.ldsrc = DM; d.scale = nullptr; d.dst = (bf16_t*)(ws + WS_WOUT) + (size_t)l * DM * DM; d.K = DM; d.nsrc0 = d.nt * 64; d.nvalid = 64; }
    else if (r < 2240) { r -= 1216; d.kt = r / 64; d.nt = r % 64; d.src = p.w_ff1 + (size_t)l * DM * DFF; d.ldsrc = DFF; d.scale = p.norm2_w + l * DM; d.dst = (bf16_t*)(ws + WS_WFF1) + (size_t)l * DFF * DM; d.K = DM; d.nsrc0 = d.nt * 64; d.nvalid = 64; }
    else { r -= 2240; d.kt = r / 16; d.nt = r % 16; d.src = p.w_ff2 + (size_t)l * DFF * DM; d.ldsrc = DM; d.scale = nullptr; d.dst = (bf16_t*)(ws + WS_WFF2) + (size_t)l * DM * DFF; d.K = DFF; d.nsrc0 = d.nt * 64; d.nvalid = 64; }
    return d;
}
__device__ __forceinline__ void prep_phase(const Params& p, LAS unsigned char* lds) {
    const int tid = opaque_tid();
    unsigned char* ws = p.ws;
    constexpr int NT = 4;
    for (int t = blockIdx.x; t < 6528; t += NT * gridDim.x) {
        WtDesc d[NT]; f32x4 v[NT][2]; float sc[NT][2]; bool has[NT];
#pragma unroll
        for (int q = 0; q < NT; ++q) { const int tq = t + q * gridDim.x; has[q] = tq < 6528; d[q] = wt_desc(p, has[q] ? tq : t);
#pragma unroll
            for (int it = 0; it < 2; ++it) { const int kk = (tid >> 4) + 32 * it, n4 = (tid & 15) * 4;
                v[q][it] = (f32x4){0.f, 0.f, 0.f, 0.f};
                if (n4 < d[q].nvalid) v[q][it] = __builtin_nontemporal_load((const f32x4*)(d[q].src + (size_t)(d[q].kt * 64 + kk) * d[q].ldsrc + d[q].nsrc0 + n4));
                sc[q][it] = d[q].scale ? d[q].scale[d[q].kt * 64 + kk] : 1.0f; } }
#pragma unroll
        for (int q = 0; q < NT; ++q) { LAS float* T = (LAS float*)lds + q * 4160;
#pragma unroll
            for (int it = 0; it < 2; ++it) { const int kk = (tid >> 4) + 32 * it, n4 = (tid & 15) * 4;
#pragma unroll
                for (int e = 0; e < 4; ++e) T[(n4 + e) * 65 + kk] = v[q][it][e] * sc[q][it]; } }
        __syncthreads();
#pragma unroll
        for (int q = 0; q < NT; ++q) if (has[q]) { const LAS float* T = (const LAS float*)lds + q * 4160; const int n = tid >> 3, k8 = (tid & 7) * 8; float f[8];
#pragma unroll
            for (int e = 0; e < 8; ++e) f[e] = T[n * 65 + k8 + e];
            u32x4 w; w.x = cvt_pk_bf16(f[0], f[1]); w.y = cvt_pk_bf16(f[2], f[3]); w.z = cvt_pk_bf16(f[4], f[5]); w.w = cvt_pk_bf16(f[6], f[7]);
            *(u32x4*)(d[q].dst + (size_t)(d[q].nt * 64 + n) * d[q].K + d[q].kt * 64 + k8) = w; }
        __syncthreads();
    }
    const int wave = tid >> 6, lane = tid & 63;
    bf16_t* XB = (bf16_t*)(ws + WS_XB); ssq_t* ssq = (ssq_t*)(ws + WS_SSQ);
    for (int t = blockIdx.x; t < MROWS / 16; t += gridDim.x) {
        f32x4 v[2][4];
#pragma unroll
        for (int q = 0; q < 2; ++q) { const f32x4* xr = (const f32x4*)(p.x + (size_t)(t * 16 + wave * 2 + q) * DM);
#pragma unroll
            for (int it = 0; it < 4; ++it) v[q][it] = __builtin_nontemporal_load(xr + it * 64 + lane); }
#pragma unroll
        for (int q = 0; q < 2; ++q) { const int row = t * 16 + wave * 2 + q; float s = 0.f;
#pragma unroll
            for (int it = 0; it < 4; ++it) { const f32x4 x = v[q][it]; s += (x[0] * x[0] + x[1] * x[1]) + (x[2] * x[2] + x[3] * x[3]);
                u32x2 w; w.x = cvt_pk_bf16(x[0], x[1]); w.y = cvt_pk_bf16(x[2], x[3]); *(u32x2*)(XB + (size_t)row * DM + (it * 64 + lane) * 4) = w; }
#pragma unroll
            for (int o = 32; o >= 1; o >>= 1) s += __shfl_xor(s, o);
            if (lane == 0) ssq[row] = ssq_enc(s); }
    }
    for (int i = blockIdx.x * 512 + tid; i < 4 * MROWS; i += gridDim.x * 512) ssq[MROWS + i] = 0u;
}

__device__ __forceinline__ void conv_phase(const Params& p, int l) {
    const int tid = opaque_tid(), cgp = tid & 127, rg = tid >> 7, c0 = cgp * 8;
    const bf16_t* PROJ = (const bf16_t*)(p.ws + WS_R1); bf16_t* QKC = (bf16_t*)(p.ws + WS_QKC);
    const float* cw = p.conv_w + (size_t)l * 3 * 1024; const float* cb = p.conv_b + (size_t)l * 1024;
    float w0[8], w1[8], w2[8], bb[8];
#pragma unroll
    for (int e = 0; e < 8; ++e) { w0[e] = cw[c0 + e]; w1[e] = cw[1024 + c0 + e]; w2[e] = cw[2048 + c0 + e]; bb[e] = cb[c0 + e]; }
    const float ksc = (c0 >= 512) ? 0.08838834764831845f : 1.0f;
    for (int t = blockIdx.x; t < MROWS / 16; t += gridDim.x) {
        const int r0 = t * 16 + rg * 4;
        u32x4 rw[6];
#pragma unroll
        for (int q = 0; q < 6; ++q) {
            const bool ok = !((q == 0 && (r0 & (SEQ - 1)) == 0) || (q == 5 && ((r0 + 3) & (SEQ - 1)) == SEQ - 1));
            rw[q] = (u32x4){0u, 0u, 0u, 0u};
            if (ok) rw[q] = *(const u32x4*)(PROJ + (size_t)(r0 - 1 + q) * NPROJ + c0);
        }
#pragma unroll
        for (int i = 0; i < 4; ++i) {
            float y[8];
#pragma unroll
            for (int e2 = 0; e2 < 4; ++e2) {
                const float a0 = bf_lo(rw[i][e2]), a1 = bf_hi(rw[i][e2]), b0 = bf_lo(rw[i + 1][e2]), b1 = bf_hi(rw[i + 1][e2]), c0f = bf_lo(rw[i + 2][e2]), c1f = bf_hi(rw[i + 2][e2]);
                y[2 * e2] = w0[2 * e2] * a0 + w1[2 * e2] * b0 + w2[2 * e2] * c0f + bb[2 * e2];
                y[2 * e2 + 1] = w0[2 * e2 + 1] * a1 + w1[2 * e2 + 1] * b1 + w2[2 * e2 + 1] * c1f + bb[2 * e2 + 1];
            }
#pragma unroll
            for (int e = 0; e < 8; ++e) y[e] = y[e] / (1.0f + __expf(-y[e])) * ksc;
            u32x4 w; w.x = cvt_pk_bf16(y[0], y[1]); w.y = cvt_pk_bf16(y[2], y[3]); w.z = cvt_pk_bf16(y[4], y[5]); w.w = cvt_pk_bf16(y[6], y[7]);
            *(u32x4*)(QKC + (size_t)(r0 + i) * DM + c0) = w;
        }
    }
}

constexpr int NA_VSTR = 144;
constexpr int NA_KR = 0, NA_VR = 8 * 64 * 128, NA_MRG = NA_VR + 8 * 64 * NA_VSTR, NA_BT = NA_MRG + 2 * 4 * 10 * 64 * 4, NA_END = NA_BT + 15 * 32 * 4;
static_assert(NA_END <= LDS_BYTES - 16, "NA LDS");
__device__ __forceinline__ void na_phase(const Params& p, int l, LAS unsigned char* lds, bool probe = false) {
    const int tid = opaque_tid(), w = __builtin_amdgcn_readfirstlane(tid >> 6), lane = tid & 63, g = lane >> 4, c = lane & 15;
    bf16_t* PROJ = (bf16_t*)(p.ws + WS_R1);
    const int half = w >> 2, qt = w & 3, c0 = qt * 16;
    const int wsn = (c0 - 8 < 0) ? 0 : ((c0 - 8 > 32) ? 32 : c0 - 8);
    const int qc = c0 + c;
    const int cs = (qc - 8 < 0) ? 0 : ((qc - 8 > 48) ? 48 : qc - 8);
    int rc[2][4];
#pragma unroll
    for (int kt = 0; kt < 2; ++kt)
#pragma unroll
        for (int i = 0; i < 4; ++i) { const int kc = wsn + kt * 16 + 4 * g + i; rc[kt][i] = ((kc >= cs) && (kc < cs + 16)) ? (kc - qc + 15) : 31; }
    const int skey = tid >> 3, sch = tid & 7;
    const int skoff = skey * 128 + ((sch ^ (skey & 7)) * 16), svoff = skey * NA_VSTR + sch * 16;
    LAS float* bt = (LAS float*)(lds + NA_BT);
    for (int task = blockIdx.x; task < 256; task += gridDim.x) {
        const int head = task & 7, strip = (task >> 3) & 3, b = task >> 5;
        const int r0 = strip * 16;
        const bf16_t* kvbase = PROJ + ((size_t)b * SEQ + skey) * NPROJ + 2560 + head * 64 + sch * 8;
        int rs = (r0 - 4 < 0) ? 0 : ((r0 - 4 > 56) ? 56 : r0 - 4);
        __syncthreads();
        { u32x4 kk8[8], vv8[8];
#pragma unroll
          for (int j = 0; j < 8; ++j) { const bf16_t* src = kvbase + (size_t)(rs + j) * 64 * NPROJ; kk8[j] = *(const u32x4*)src; vv8[j] = *(const u32x4*)(src + 512); }
#pragma unroll
          for (int j = 0; j < 8; ++j) { const int slot = (rs + j) & 7; *(LAS u32x4*)(lds + NA_KR + slot * 8192 + skoff) = kk8[j]; *(LAS u32x4*)(lds + NA_VR + slot * 9216 + svoff) = vv8[j]; } }
        if (tid < 480) { const int br_ = tid >> 5, bc_ = tid & 31; bt[tid] = (bc_ < 31) ? p.rpb[(size_t)l * 8 * 465 + (size_t)head * 465 + br_ * 31 + bc_] * 1.4426950408889634f : -1e30f; }
        bf16x8 qf[2];
        { const size_t qtok = (size_t)b * SEQ + (size_t)r0 * 64 + c0 + c;
#pragma unroll
          for (int kk = 0; kk < 2; ++kk) qf[kk] = *(const bf16x8*)(PROJ + qtok * NPROJ + 2048 + head * 64 + kk * 32 + g * 8); }
        LDS_BARRIER();
        float breg[4][2][4]; int boff = 0x7fffffff;
#pragma unroll 1
        for (int ri = 0; ri < 16; ++ri) {
            const int r = r0 + ri;
            if (rs - r != boff) { boff = rs - r;
#pragma unroll
                for (int j = 0; j < 4; ++j)
#pragma unroll
                    for (int kt = 0; kt < 2; ++kt)
#pragma unroll
                        for (int i = 0; i < 4; ++i) breg[j][kt][i] = bt[(boff + 4 * half + j + 7) * 32 + rc[kt][i]]; }
            const size_t qtok = (size_t)b * SEQ + (size_t)r * 64 + c0 + c;
            const int rn = (ri < 15) ? r + 1 : r;
            const int rsn = (rn - 4 < 0) ? 0 : ((rn - 4 > 56) ? 56 : rn - 4);
            const bool slide = rsn != rs;
            const bf16_t* nsrc = kvbase + (size_t)(rsn + 7) * 64 * NPROJ;
            const u32x4 nk = *(const u32x4*)nsrc, nv = *(const u32x4*)(nsrc + 512);
            bf16x8 qfn[2];
            { const size_t qtokn = (size_t)b * SEQ + (size_t)rn * 64 + c0 + c;
#pragma unroll
              for (int kk = 0; kk < 2; ++kk) qfn[kk] = *(const bf16x8*)(PROJ + qtokn * NPROJ + 2048 + head * 64 + kk * 32 + g * 8); }
            __builtin_amdgcn_sched_barrier(0);
            f32x4 sc[4][2];
#pragma unroll
            for (int j = 0; j < 4; ++j) { const int slot = (rs + 4 * half + j) & 7;
#pragma unroll
                for (int kt = 0; kt < 2; ++kt) { f32x4 a = (f32x4){0.f, 0.f, 0.f, 0.f}; const int key = wsn + kt * 16 + c;
#pragma unroll
                    for (int kk = 0; kk < 2; ++kk) { const bf16x8 kfr = *(const LAS bf16x8*)(lds + NA_KR + slot * 8192 + key * 128 + (((kk * 4 + g) ^ (key & 7)) * 16)); a = mfma16(kfr, qf[kk], a); }
                    sc[j][kt] = a; } }
            float mrun = -1e30f;
#pragma unroll
            for (int j = 0; j < 4; ++j) {
#pragma unroll
                for (int kt = 0; kt < 2; ++kt)
#pragma unroll
                    for (int i = 0; i < 4; ++i) { const float sv = sc[j][kt][i] * 0.18033688011112042f + breg[j][kt][i]; sc[j][kt][i] = sv; mrun = fmaxf(mrun, sv); } }
            mrun = fmaxf(mrun, __shfl_xor(mrun, 16)); mrun = fmaxf(mrun, __shfl_xor(mrun, 32));
            float lrun = 0.f;
#pragma unroll
            for (int j = 0; j < 4; ++j)
#pragma unroll
                for (int kt = 0; kt < 2; ++kt)
#pragma unroll
                    for (int i = 0; i < 4; ++i) { const float pv = __builtin_amdgcn_exp2f(sc[j][kt][i] - mrun); sc[j][kt][i] = pv; lrun += pv; }
            lrun += __shfl_xor(lrun, 16); lrun += __shfl_xor(lrun, 32);
            f32x4 O[4];
#pragma unroll
            for (int dt = 0; dt < 4; ++dt) O[dt] = (f32x4){0.f, 0.f, 0.f, 0.f};
#pragma unroll
            for (int j = 0; j < 4; ++j) { const int slot = (rs + 4 * half + j) & 7;
                u32x4 pw; pw.x = cvt_pk_bf16(sc[j][0][0], sc[j][0][1]); pw.y = cvt_pk_bf16(sc[j][0][2], sc[j][0][3]); pw.z = cvt_pk_bf16(sc[j][1][0], sc[j][1][1]); pw.w = cvt_pk_bf16(sc[j][1][2], sc[j][1][3]);
                const bf16x8 pf = __builtin_bit_cast(bf16x8, pw);
                LAS unsigned char* vb = lds + NA_VR + slot * 9216 + (wsn + 4 * g + (c >> 2)) * NA_VSTR + (c & 3) * 8;
#pragma unroll
                for (int dt = 0; dt < 4; ++dt) { const s16x4 t0 = tr_read(vb + dt * 32), t1 = tr_read(vb + 16 * NA_VSTR + dt * 32); O[dt] = mfma16(cat4(t0, t1), pf, O[dt]); }
            }
            LDS_BARRIER();
            LAS float* MS = (LAS float*)(lds + NA_MRG) + (half * 4 + qt) * 10 * 64 + lane;
            const LAS float* MR = (const LAS float*)(lds + NA_MRG) + ((half ^ 1) * 4 + qt) * 10 * 64 + lane;
            const f32x4 kp0 = half ? O[2] : O[0], kp1 = half ? O[3] : O[1], sd0 = half ? O[0] : O[2], sd1 = half ? O[1] : O[3];
            MS[0] = mrun; MS[64] = lrun;
#pragma unroll
            for (int i = 0; i < 4; ++i) { MS[(2 + i) * 64] = sd0[i]; MS[(6 + i) * 64] = sd1[i]; }
            if (slide) { const int slot = (rsn + 7) & 7; *(LAS u32x4*)(lds + NA_KR + slot * 8192 + skoff) = nk; *(LAS u32x4*)(lds + NA_VR + slot * 9216 + svoff) = nv; }
            LDS_BARRIER();
            {
                const float m1 = MR[0], l1 = MR[64];
                const float m = fmaxf(mrun, m1), a0 = __builtin_amdgcn_exp2f(mrun - m), a1 = __builtin_amdgcn_exp2f(m1 - m);
                const float inv = 1.0f / (lrun * a0 + l1 * a1);
                f32x4 o0, o1;
#pragma unroll
                for (int i = 0; i < 4; ++i) { o0[i] = (kp0[i] * a0 + MR[(2 + i) * 64] * a1) * inv; o1[i] = (kp1[i] * a0 + MR[(6 + i) * 64] * a1) * inv; }
                u32x2 w0, w1; w0.x = cvt_pk_bf16(o0[0], o0[1]); w0.y = cvt_pk_bf16(o0[2], o0[3]); w1.x = cvt_pk_bf16(o1[0], o1[1]); w1.y = cvt_pk_bf16(o1[2], o1[3]);
                bf16_t* op = PROJ + qtok * NPROJ + 2048 + head * 64 + half * 32 + 4 * g;
                *(u32x2*)op = w0; *(u32x2*)(op + 16) = w1;
            }
            rs = rsn; qf[0] = qfn[0]; qf[1] = qfn[1];
        }
    }
    __syncthreads();
}

constexpr int ML_QSTR = 272, ML_VSTR = 112, ML_PSTR = 144, ML_SCB = 1536;
constexpr int ML_QS = 0, ML_KS = ML_QS + 2 * 64 * ML_QSTR, ML_VS = ML_KS + 2 * 64 * ML_QSTR, ML_VG = ML_VS + 2 * 64 * ML_VSTR, ML_PS = ML_VG + 2 * 64 * ML_VSTR,
              ML_CS = ML_PS + 2 * 64 * ML_PSTR, ML_SC = ML_CS + 2 * 48 * ML_QSTR, ML_END = ML_SC + 3 * ML_SCB;
static_assert(ML_END <= LDS_BYTES - 16, "mLSTM LDS");
#define ML_TOK(n, j) (tokb + (size_t)(dir ? (SEQ - 1 - ((n) * 64 + (j))) : ((n) * 64 + (j))))
__device__ __forceinline__ void mpre_phase(const Params& p, int l) {
    const int tid = opaque_tid(), w = tid >> 6, lane = tid & 63, g = lane >> 4, c = lane & 15;
    const bf16_t* QKC = (const bf16_t*)(p.ws + WS_QKC); const float* G = (const float*)(p.ws + WS_G); bf16_t* PBUF = (bf16_t*)(p.ws + WS_PBUF);
    for (int inst = blockIdx.x * 8 + w; inst < 4096; inst += gridDim.x * 8) {
        const int n = inst & 63, dir = (inst >> 6) & 1, h = (inst >> 7) & 3, b = inst >> 9;
        const size_t tokb = (size_t)b * SEQ;
        const size_t tk = ML_TOK(n, lane);
        const float ig = G[tk * 16 + (2 * dir) * 4 + h] + p.gate_b[l * 16 + (2 * dir) * 4 + h], fp = G[tk * 16 + (2 * dir + 1) * 4 + h] + p.gate_b[l * 16 + (2 * dir + 1) * 4 + h];
        bf16x8 kf[4][4], qf[4][4];
#pragma unroll
        for (int mt = 0; mt < 4; ++mt) { const size_t tkm = ML_TOK(n, 16 * mt + c);
#pragma unroll
            for (int kk = 0; kk < 4; ++kk) { kf[mt][kk] = *(const bf16x8*)(QKC + tkm * DM + 512 + h * 128 + kk * 32 + g * 8); qf[mt][kk] = *(const bf16x8*)(QKC + tkm * DM + h * 128 + kk * 32 + g * 8); } }
        float bcum = fminf(fp, 0.f) - __logf(1.0f + __expf(-fabsf(fp)));
#pragma unroll
        for (int o = 1; o < 64; o <<= 1) { const float t_ = __shfl_up(bcum, o); if (lane >= o) bcum += t_; }
        const float u = ig - bcum; float cm = u;
#pragma unroll
        for (int o = 1; o < 64; o <<= 1) { const float t_ = __shfl_up(cm, o); if (lane >= o) cm = fmaxf(cm, t_); }
        { float* sl = (float*)(p.ws + WS_SCAL) + (size_t)inst * 192; sl[lane] = bcum; sl[64 + lane] = u; sl[128 + lane] = cm; }
        bf16_t* pb = PBUF + (size_t)inst * 4096;
#pragma unroll
        for (int mt = 0; mt < 4; ++mt)
#pragma unroll
            for (int nt = 0; nt < 4; ++nt) { u32x2 pw = (u32x2){0u, 0u};
                if (mt <= nt) { f32x4 a = (f32x4){0.f, 0.f, 0.f, 0.f};
#pragma unroll
                    for (int kk = 0; kk < 4; ++kk) a = mfma16(kf[mt][kk], qf[nt][kk], a);
                    const float cmj = __shfl(cm, 16 * nt + c); float pv[4];
#pragma unroll
                    for (int i = 0; i < 4; ++i) { const int s_ = 16 * mt + 4 * g + i; const float us = __shfl(u, s_); pv[i] = (s_ <= 16 * nt + c) ? __expf(us - cmj) * a[i] : 0.f; }
                    pw.x = cvt_pk_bf16(pv[0], pv[1]); pw.y = cvt_pk_bf16(pv[2], pv[3]); }
                *(u32x2*)(pb + (16 * nt + c) * 64 + 16 * mt + 4 * g) = pw; }
    }
}

__device__ __forceinline__ void mlstm_phase(const Params& p, int l, LAS unsigned char* lds) {
    const int tid = opaque_tid(), w = __builtin_amdgcn_readfirstlane(tid >> 6), lane = tid & 63, g = lane >> 4, c = lane & 15;
    bf16_t* PROJ = (bf16_t*)(p.ws + WS_R1); const bf16_t* QKC = (const bf16_t*)(p.ws + WS_QKC); const float* G = (const float*)(p.ws + WS_G);
    const bf16_t* PBUF = (const bf16_t*)(p.ws + WS_PBUF);
    for (int task = blockIdx.x; task < 256; task += gridDim.x) {
        const int xq = task & 7, yq = task >> 3, vs = yq & 3, dir = (yq >> 2) & 1, bh = xq + 8 * (yq >> 3), h = bh & 3, b = bh >> 2;
        const size_t tokb = (size_t)b * SEQ;
        const bf16_t* pbase = PBUF + (size_t)(((b * 4 + h) * 2 + dir) * 64) * 4096 + (tid >> 3) * 64 + (tid & 7) * 8;
        const float gbi = p.gate_b[l * 16 + (2 * dir) * 4 + h], gbf = p.gate_b[l * 16 + (2 * dir + 1) * 4 + h];
        float mprev_chain = 0.f;
        __syncthreads();
        for (int i = tid; i < 48 * ML_QSTR / 4; i += 512) ((LAS unsigned*)(lds + ML_CS))[i] = 0u;
#define ML_GLOAD(n) do { const float* sl_ = scal + (size_t)(n) * 192; g_b = sl_[lane]; g_u = sl_[64 + lane]; g_cm = sl_[128 + lane]; } while (0)
#define ML_SCAN(sci) do { \
            const float Mj_ = fmaxf(mprev_chain, g_cm); \
            const float M63_ = __builtin_bit_cast(float, __builtin_amdgcn_readlane(__builtin_bit_cast(int, Mj_), 63)), tot_ = __builtin_bit_cast(float, __builtin_amdgcn_readlane(__builtin_bit_cast(int, g_b), 63)); \
            LAS float* sc_ = (LAS float*)(lds + ML_SC + (sci) * ML_SCB); \
            sc_[lane] = g_b; sc_[128 + lane] = Mj_; sc_[192 + lane] = __expf(g_u - M63_); sc_[320 + lane] = __expf(g_cm - Mj_); \
            if (lane == 0) { sc_[256] = __expf(mprev_chain - M63_); sc_[257] = mprev_chain; } \
            mprev_chain = tot_ + M63_; } while (0)
        const float* scal = (const float*)(p.ws + WS_SCAL) + (size_t)(((b * 4 + h) * 2 + dir) * 64) * 192;
        float g_b = 0.f, g_u = 0.f, g_cm = 0.f;
        if (w == 7) { ML_GLOAD(0); ML_SCAN(0); ML_GLOAD(1); ML_SCAN(1); }
        u32x4 qreg[1][2], kreg[1][2], vreg[1], preg[1];
        const long dtok = dir ? -1 : 1;
        const bf16_t* qp0 = QKC + ML_TOK(0, tid >> 4) * DM + h * 128 + (tid & 15) * 8;
        const bf16_t* vp = PROJ + ML_TOK(0, tid >> 2) * NPROJ + 1024 + h * 128 + vs * 32 + (tid & 3) * 8;
        const bf16_t* pp = pbase;
#define ML_LOAD(n, rs_) do { \
            qreg[rs_][0] = *(const u32x4*)(qp0); kreg[rs_][0] = *(const u32x4*)(qp0 + 512); \
            qreg[rs_][1] = *(const u32x4*)(qp0 + dtok * 32 * DM); kreg[rs_][1] = *(const u32x4*)(qp0 + dtok * 32 * DM + 512); \
            preg[rs_] = *(const u32x4*)(pp); \
            if (tid < 256) vreg[rs_] = *(const u32x4*)(vp); \
            qp0 += dtok * 64 * DM; vp += dtok * 64 * NPROJ; pp += 4096; } while (0)
#define ML_STORE(bufi, sci, rs_) do { \
            _Pragma("unroll") for (int it = 0; it < 2; ++it) { const int pc = it * 512 + tid, j = pc >> 4, part = pc & 15; \
                *(LAS u32x4*)(lds + ML_QS + (bufi) * 64 * ML_QSTR + j * ML_QSTR + part * 16) = qreg[rs_][it]; *(LAS u32x4*)(lds + ML_KS + (bufi) * 64 * ML_QSTR + j * ML_QSTR + part * 16) = kreg[rs_][it]; } \
            *(LAS u32x4*)(lds + ML_PS + (bufi) * 64 * ML_PSTR + (tid >> 3) * ML_PSTR + (tid & 7) * 16) = preg[rs_]; \
            const LAS float* scg_ = (const LAS float*)(lds + ML_SC + (sci) * ML_SCB + 192 * 4); \
            if (tid < 256) { const int j = tid >> 2, part = tid & 3; const float gj = scg_[j]; \
                *(LAS u32x4*)(lds + ML_VS + (bufi) * 64 * ML_VSTR + j * ML_VSTR + part * 16) = vreg[rs_]; u32x4 vg; \
                _Pragma("unroll") for (int e = 0; e < 4; ++e) vg[e] = cvt_pk_bf16(bf_lo(vreg[rs_][e]) * gj, bf_hi(vreg[rs_][e]) * gj); \
                *(LAS u32x4*)(lds + ML_VG + (bufi) * 64 * ML_VSTR + j * ML_VSTR + part * 16) = vg; } \
            else if (tid < 320) { const int j = tid - 256; const float gj = scg_[j]; \
                *(LAS u32x4*)(lds + ML_VS + (bufi) * 64 * ML_VSTR + j * ML_VSTR + 64) = (u32x4){0x3F80u, 0u, 0u, 0u}; *(LAS u32x4*)(lds + ML_VS + (bufi) * 64 * ML_VSTR + j * ML_VSTR + 80) = (u32x4){0u, 0u, 0u, 0u}; \
                *(LAS u32x4*)(lds + ML_VG + (bufi) * 64 * ML_VSTR + j * ML_VSTR + 64) = (u32x4){cvt_pk_bf16(gj, 0.f), 0u, 0u, 0u}; *(LAS u32x4*)(lds + ML_VG + (bufi) * 64 * ML_VSTR + j * ML_VSTR + 80) = (u32x4){0u, 0u, 0u, 0u}; } } while (0)
        ML_LOAD(0, 0);
        __syncthreads();
        ML_STORE(0, 0, 0);
        __syncthreads();
        f32x4 CT[2][3];
#pragma unroll
        for (int a = 0; a < 2; ++a)
#pragma unroll
            for (int v = 0; v < 3; ++v) CT[a][v] = (f32x4){0.f, 0.f, 0.f, 0.f};
        int s0 = 0, s1 = 1, s2 = 2;
        bf16_t* hp = PROJ + ML_TOK(0, 16 * (w & 3) + c) * NPROJ + dir * 512 + h * 128 + vs * 32 + 4 * g;
#define ML_STEP_BODY \
            LAS unsigned char* QS = lds + ML_QS + buf * 64 * ML_QSTR; LAS unsigned char* KS = lds + ML_KS + buf * 64 * ML_QSTR; \
            LAS unsigned char* VS = lds + ML_VS + buf * 64 * ML_VSTR; LAS unsigned char* VG = lds + ML_VG + buf * 64 * ML_VSTR; \
            LAS unsigned char* PS = lds + ML_PS + buf * 64 * ML_PSTR; LAS unsigned char* CS = lds + ML_CS + buf * 48 * ML_QSTR; LAS unsigned char* CSn = lds + ML_CS + nb * 48 * ML_QSTR; \
            const LAS float* sc = (const LAS float*)(lds + ML_SC + s0 * ML_SCB); \
            u32x2 hw[2] = {(u32x2){0u, 0u}, (u32x2){0u, 0u}}; \
            if (n + 1 < 64) ML_LOAD(n + 1, 0); \
            if (w == 7 && n + 2 < 64) ML_GLOAD(n + 2); \
            if (w < 4) { \
                const float mprev = sc[257]; \
                bf16x8 qa[4]; \
_Pragma("unroll") \
                for (int kk = 0; kk < 4; ++kk) qa[kk] = *(const LAS bf16x8*)(QS + (16 * w + c) * ML_QSTR + kk * 64 + g * 16); \
                bf16x8 pa[2]; \
_Pragma("unroll") \
                for (int kk = 0; kk < 2; ++kk) pa[kk] = *(const LAS bf16x8*)(PS + (16 * w + c) * ML_PSTR + kk * 64 + g * 16); \
                const int jj = 16 * w + c; const float Mj = sc[128 + jj]; \
                const float wi = __expf(mprev - Mj), em = __expf(-(sc[jj] + Mj)), rho = sc[320 + jj]; \
                f32x4 num[3]; \
_Pragma("unroll") \
                for (int vt = 0; vt < 3; ++vt) { f32x4 a = (f32x4){0.f, 0.f, 0.f, 0.f}, a2 = (f32x4){0.f, 0.f, 0.f, 0.f}; \
_Pragma("unroll") \
                    for (int kk = 0; kk < 4; ++kk) { const bf16x8 cf = *(const LAS bf16x8*)(CS + (16 * vt + c) * ML_QSTR + kk * 64 + g * 16); a = mfma16(cf, qa[kk], a); } \
_Pragma("unroll") \
                    for (int kk = 0; kk < 2; ++kk) { LAS unsigned char* vb = VS + (32 * kk + 8 * g + (c >> 2)) * ML_VSTR + vt * 32 + (c & 3) * 8; \
                        const s16x4 t0 = tr_read(vb), t1 = tr_read(vb + 4 * ML_VSTR); a2 = mfma16(cat4(t0, t1), pa[kk], a2); } \
                    num[vt] = a * wi + a2 * rho; } \
                const float den = __shfl(num[2][0], c); const float inv = 1.0f / fmaxf(fabsf(den), em); \
_Pragma("unroll") \
                for (int vt = 0; vt < 2; ++vt) { const f32x4 o = num[vt] * inv; hw[vt].x = cvt_pk_bf16(o[0], o[1]); hw[vt].y = cvt_pk_bf16(o[2], o[3]); } \
            } else { \
                const int ww = w - 4; const float decay = sc[256]; \
_Pragma("unroll") \
                for (int a = 0; a < 2; ++a) \
_Pragma("unroll") \
                    for (int v = 0; v < 3; ++v) CT[a][v] = CT[a][v] * decay; \
_Pragma("unroll") \
                for (int kk = 0; kk < 2; ++kk) { bf16x8 af[2], bfr[3]; \
_Pragma("unroll") \
                    for (int a = 0; a < 2; ++a) { LAS unsigned char* kb = KS + (32 * kk + 8 * g + (c >> 2)) * ML_QSTR + (2 * ww + a) * 32 + (c & 3) * 8; af[a] = cat4(tr_read(kb), tr_read(kb + 4 * ML_QSTR)); } \
_Pragma("unroll") \
                    for (int v = 0; v < 3; ++v) { LAS unsigned char* vb = VG + (32 * kk + 8 * g + (c >> 2)) * ML_VSTR + v * 32 + (c & 3) * 8; bfr[v] = cat4(tr_read(vb), tr_read(vb + 4 * ML_VSTR)); } \
_Pragma("unroll") \
                    for (int a = 0; a < 2; ++a) \
_Pragma("unroll") \
                        for (int v = 0; v < 3; ++v) CT[a][v] = mfma16(af[a], bfr[v], CT[a][v]); } \
_Pragma("unroll") \
                for (int a = 0; a < 2; ++a) \
_Pragma("unroll") \
                    for (int v = 0; v < 3; ++v) { u32x2 cw; cw.x = cvt_pk_bf16(CT[a][v][0], CT[a][v][1]); cw.y = cvt_pk_bf16(CT[a][v][2], CT[a][v][3]); \
                        *(LAS u32x2*)(CSn + (16 * v + c) * ML_QSTR + (16 * (2 * ww + a) + 4 * g) * 2) = cw; } \
                if (w == 7 && n + 2 < 64) { ML_SCAN(s2); } \
            } \
            if (n + 1 < 64) ML_STORE(nb, s1, 0); \
            if (w < 4) { *(u32x2*)(hp) = hw[0]; *(u32x2*)(hp + 16) = hw[1]; } \
            LDS_BARRIER(); \
            { const int t_ = s0; s0 = s1; s1 = s2; s2 = t_; } \
            hp += dtok * 64 * NPROJ;
#pragma unroll 1
        for (int n2 = 0; n2 < 64; n2 += 2) {
            { constexpr int buf = 0, nb = 1; const int n = n2; ML_STEP_BODY }
            { constexpr int buf = 1, nb = 0; const int n = n2 + 1; ML_STEP_BODY }
        }
#undef ML_STEP_BODY
#undef ML_SCAN
#undef ML_GLOAD
#undef ML_LOAD
#undef ML_STORE
    }
}
#undef ML_TOK

__device__ __forceinline__ void combine_phase(const Params& p, int l) {
    const int tid = opaque_tid(), wave = tid >> 6, lane = tid & 63, col = lane * 8;
    bf16_t* PROJ = (bf16_t*)(p.ws + WS_R1);
    float nw[8];
#pragma unroll
    for (int e = 0; e < 8; ++e) nw[e] = p.mnorm_w[l * 512 + col + e];
    for (int t32 = blockIdx.x; t32 < MROWS / 32; t32 += gridDim.x) {
        u32x4 hf[4], hb[4], ov[4];
#pragma unroll
        for (int q = 0; q < 4; ++q) { const bf16_t* base = PROJ + (size_t)(t32 * 32 + wave * 4 + q) * NPROJ;
            hf[q] = *(const u32x4*)(base + col); hb[q] = *(const u32x4*)(base + 512 + col); ov[q] = *(const u32x4*)(base + 1536 + col); }
#pragma unroll
        for (int q = 0; q < 4; ++q) {
            float hv[8], ss = 0.f;
#pragma unroll
            for (int e = 0; e < 4; ++e) { hv[2 * e] = bf_lo(hf[q][e]) + bf_lo(hb[q][e]); hv[2 * e + 1] = bf_hi(hf[q][e]) + bf_hi(hb[q][e]); ss += hv[2 * e] * hv[2 * e] + hv[2 * e + 1] * hv[2 * e + 1]; }
            ss += __shfl_xor(ss, 1); ss += __shfl_xor(ss, 2); ss += __shfl_xor(ss, 4); ss += __shfl_xor(ss, 8);
            const float rs = rsqrtf(ss * (1.0f / 128.0f) + EPS);
            float y[8];
#pragma unroll
            for (int e = 0; e < 4; ++e) { const float o0 = bf_lo(ov[q][e]), o1 = bf_hi(ov[q][e]);
                y[2 * e] = hv[2 * e] * rs * nw[2 * e] / (1.0f + __expf(-o0)); y[2 * e + 1] = hv[2 * e + 1] * rs * nw[2 * e + 1] / (1.0f + __expf(-o1)); }
            u32x4 wv; wv.x = cvt_pk_bf16(y[0], y[1]); wv.y = cvt_pk_bf16(y[2], y[3]); wv.z = cvt_pk_bf16(y[4], y[5]); wv.w = cvt_pk_bf16(y[6], y[7]);
            *(u32x4*)(PROJ + (size_t)(t32 * 32 + wave * 4 + q) * NPROJ + 1536 + col) = wv;
        }
    }
}

__device__ __forceinline__ void final_phase(const Params& p) {
    const int tid = opaque_tid(); const ssq_t* ssq = (const ssq_t*)(p.ws + WS_SSQ) + 4 * MROWS; const bf16_t* XB = (const bf16_t*)(p.ws + WS_XB);
    const int c8 = (tid & 127) * 8;
    const f32x4 fw0 = *(const f32x4*)(p.fnorm_w + c8), fw1 = *(const f32x4*)(p.fnorm_w + c8 + 4);
    for (int r16 = blockIdx.x; r16 < MROWS / 16; r16 += gridDim.x) {
        u32x4 v[4]; float rs[4];
#pragma unroll
        for (int q = 0; q < 4; ++q) { const int row = r16 * 16 + q * 4 + (tid >> 7); v[q] = *(const u32x4*)(XB + (size_t)row * DM + c8); rs[q] = ssq_dec(ssq[row]); }
#pragma unroll
        for (int q = 0; q < 4; ++q) { const int row = r16 * 16 + q * 4 + (tid >> 7); const float r_ = rsqrtf(rs[q] * (1.0f / DM) + EPS);
            const f32x4 a = (f32x4){bf_lo(v[q].x), bf_hi(v[q].x), bf_lo(v[q].y), bf_hi(v[q].y)}, b = (f32x4){bf_lo(v[q].z), bf_hi(v[q].z), bf_lo(v[q].w), bf_hi(v[q].w)};
            float* op = p.out + (size_t)row * DM + c8;
            *(f32x4*)op = a * r_ * fw0; *(f32x4*)(op + 4) = b * r_ * fw1; }
    }
}

__device__ __forceinline__ void gates_phase(const Params& p, int l, const ssq_t* ssq) {
    const int tid = opaque_tid(), w = tid >> 6, lane = tid & 63, g = lane >> 4, c = lane & 15;
    const bf16_t* XB = (const bf16_t*)(p.ws + WS_XB); const bf16_t* Wg = (const bf16_t*)(p.ws + WS_WIN) + (size_t)l * NINP * DM + (size_t)NPROJ * DM;
    float* G = (float*)(p.ws + WS_G);
    for (int rb = blockIdx.x; rb < MROWS / 128; rb += gridDim.x) {
        const int row0 = rb * 128 + w * 16;
        const bf16_t* ap = XB + (size_t)(row0 + c) * DM + g * 8; const bf16_t* bp = Wg + (size_t)c * DM + g * 8;
        f32x4 acc = (f32x4){0.f, 0.f, 0.f, 0.f};
#pragma unroll 16
        for (int kk = 0; kk < 32; ++kk) { const bf16x8 a = *(const bf16x8*)(ap + kk * 32), b = *(const bf16x8*)(bp + kk * 32); acc = mfma16(a, b, acc); }
#pragma unroll
        for (int i = 0; i < 4; ++i) { const int row = row0 + 4 * g + i; G[(size_t)row * 16 + c] = acc[i] * rsqrtf(ssq_dec(ssq[row]) * (1.0f / DM) + EPS); }
    }
}

__global__ void __launch_bounds__(512, 2) fwd_kernel(Params p) {
    extern __shared__ __attribute__((aligned(16))) unsigned char smem[];
    LAS unsigned char* lds = (LAS unsigned char*)smem;
    unsigned char* ws = p.ws;
    bf16_t* XB = (bf16_t*)(ws + WS_XB); bf16_t* R1 = (bf16_t*)(ws + WS_R1); float* G = (float*)(ws + WS_G); ssq_t* ssq = (ssq_t*)(ws + WS_SSQ);
    volatile LAS unsigned* xst = (volatile LAS unsigned*)(lds + LDS_BYTES - 16);
    if (threadIdx.x < 4) xst[threadIdx.x] = 0u;
    __syncthreads();
    XcdBarrier xbar = xcd_barrier_post((unsigned*)(ws + WS_BAR), xst);
    for (int ph = p.ph_lo; ph < p.ph_hi; ++ph) {
        if (ph == 0) { if (PH_ON(0)) prep_phase(p, lds); if (REP(0)) prep_phase(p, lds); }
        else if (ph == 15) { if (PH_ON(8)) final_phase(p); }
        else {
            const int l = (ph - 1) / 7, sub = (ph - 1) % 7;
            pg8::StaticOrder S;
            if (sub == 0) { if (PH_ON(1)) {
                pg8::Gemm g; g.A = XB; g.Bt = (const bf16_t*)(ws + WS_WIN) + (size_t)l * NINP * DM; g.M = MROWS; g.N = NPROJ; g.K = DM; g.lda = DM;
                S.init(MROWS, NPROJ, gridDim.x, blockIdx.x);
                pg8::EpiProj E; E.P = R1; E.G = G; E.ssq = ssq + (size_t)(2 * l) * MROWS;
                pg8::gemm_phase(lds, g, S, E);
                if (REP(1)) pg8::gemm_phase(lds, g, S, E);
                gates_phase(p, l, E.ssq); }
            } else if (sub == 1) {
                { const int na_first = (blockIdx.x >> 3) & 1;
#pragma unroll 1
                  for (int pass = 0; pass < 2; ++pass) { if ((pass ^ na_first) == 1) na_phase(p, l, lds); else conv_phase(p, l); } }
            } else if (sub == 2) {
                if (PH_ON(4)) { mpre_phase(p, l); xcd_barrier(xbar); mlstm_phase(p, l, lds); }
                if (REP(4)) mlstm_phase(p, l, lds);
            } else if (sub == 3) {
                if (PH_ON(5)) combine_phase(p, l);
            } else if (sub == 4) { if (PH_ON(6)) {
                pg8::Gemm g; g.A = R1 + 1536; g.Bt = (const bf16_t*)(ws + WS_WOUT) + (size_t)l * DM * DM; g.M = MROWS; g.N = DM; g.K = DM; g.lda = NPROJ;
                S.init(MROWS, DM, gridDim.x, blockIdx.x);
                pg8::EpiResid E; E.XinF = (l == 0) ? p.x : nullptr; E.XinB = XB; E.XoutF = nullptr; E.XB = XB; E.ssq = ssq + (size_t)(2 * l + 1) * MROWS;
                pg8::gemm_phase(lds, g, S, E); }
            } else if (sub == 5) { if (PH_ON(7)) {
                pg8::Gemm g; g.A = XB; g.Bt = (const bf16_t*)(ws + WS_WFF1) + (size_t)l * DFF * DM; g.M = MROWS; g.N = DFF; g.K = DM; g.lda = DM;
                S.init(MROWS, DFF, gridDim.x, blockIdx.x);
                pg8::EpiFF1 E; E.H = R1; E.ssq = ssq + (size_t)(2 * l + 1) * MROWS;
                pg8::gemm_phase(lds, g, S, E);
                if (REP(7)) pg8::gemm_phase(lds, g, S, E); }
            } else { if (PH_ON(9)) {
                pg8::Gemm g; g.A = R1; g.Bt = (const bf16_t*)(ws + WS_WFF2) + (size_t)l * DM * DFF; g.M = MROWS; g.N = DM; g.K = DFF; g.lda = HLD;
                S.init(MROWS, DM, gridDim.x, blockIdx.x);
                pg8::EpiResid E; E.XinF = nullptr; E.XinB = XB; E.XoutF = nullptr; E.XB = XB; E.ssq = ssq + (size_t)(2 * l + 2) * MROWS;
                pg8::gemm_phase(lds, g, S, E); }
            }
        }
        if (ph + 1 < p.ph_hi) { if (p.ph_lo < 0) cg::this_grid().sync(); else xcd_barrier(xbar); }
        if (REP(10) && ph == 3) { for (int q = 0; q < 10; ++q) xcd_barrier(xbar); }
    }
}

extern "C" void kernel_launch(void* const* d_in, const int* in_sizes, int n_in, void* d_out, int out_size, void* d_ws, size_t ws_size, hipStream_t stream) {
    static int grid = 0;
    if (grid == 0) {
        int dev = 0, cus = 0, per_cu = 0;
        (void)hipGetDevice(&dev);
        (void)hipDeviceGetAttribute(&cus, hipDeviceAttributeMultiprocessorCount, dev);
        if (hipFuncSetAttribute((const void*)fwd_kernel, hipFuncAttributeMaxDynamicSharedMemorySize, LDS_BYTES) != hipSuccess) fprintf(stderr, "hipFuncSetAttribute failed\n");
        (void)hipOccupancyMaxActiveBlocksPerMultiprocessor(&per_cu, (const void*)fwd_kernel, 512, LDS_BYTES);
        if (per_cu < 1) { fprintf(stderr, "occupancy query says %d blocks per CU\n", per_cu); per_cu = 1; }
        grid = cus * per_cu;
        if (ws_size < WS_END) fprintf(stderr, "workspace too small: %zu < %zu\n", ws_size, (size_t)WS_END);
    }
    Params p{};
    p.x = (const float*)d_in[0]; p.norm1_w = (const float*)d_in[1]; p.w_in = (const float*)d_in[2]; p.conv_w = (const float*)d_in[3]; p.conv_b = (const float*)d_in[4];
    p.gate_b = (const float*)d_in[5]; p.mnorm_w = (const float*)d_in[6]; p.rpb = (const float*)d_in[7]; p.w_out = (const float*)d_in[8]; p.norm2_w = (const float*)d_in[9];
    p.w_ff1 = (const float*)d_in[10]; p.w_ff2 = (const float*)d_in[11]; p.fnorm_w = (const float*)d_in[12];
    p.out = (float*)d_out; p.ws = (unsigned char*)d_ws;
    (void)hipMemsetAsync((unsigned char*)d_ws + WS_BAR, 0, 16384, stream);
#if MULTI_LAUNCH
    for (int ph = 0; ph < 16; ++ph) { p.ph_lo = ph; p.ph_hi = ph + 1; hipLaunchKernelGGL(fwd_kernel, dim3(grid), dim3(512), LDS_BYTES, stream, p); }
#else
    p.ph_lo = 0; p.ph_hi = 16;
    void* args[] = {&p};
    hipError_t e = hipLaunchCooperativeKernel((const void*)fwd_kernel, dim3(grid), dim3(512), args, LDS_BYTES, stream);
    if (e != hipSuccess) fprintf(stderr, "cooperative launch failed: %s (grid %d)\n", hipGetErrorString(e), grid);
#endif
}
```

```cpp
#include <hip/hip_runtime.h>
#include <hip/hip_cooperative_groups.h>
#include <cstdio>
namespace cg = cooperative_groups;

#ifndef MULTI_LAUNCH
#define MULTI_LAUNCH 0
#endif
#ifndef PHASE_MASK
#define PHASE_MASK 0xffff
#endif
#define PH_ON(k) ((PHASE_MASK >> (k)) & 1)
#ifndef REPEAT_MASK
#define REPEAT_MASK 0
#endif
#define REP(k) ((REPEAT_MASK >> (k)) & 1)

#define LAS __attribute__((address_space(3)))
typedef unsigned short bf16_t;
typedef short bf16x8 __attribute__((ext_vector_type(8)));
typedef short s16x4 __attribute__((ext_vector_type(4)));
typedef float f32x4 __attribute__((ext_vector_type(4)));
typedef unsigned u32x4 __attribute__((ext_vector_type(4)));
typedef unsigned u32x2 __attribute__((ext_vector_type(2)));
typedef unsigned ssq_t;
__device__ __forceinline__ ssq_t ssq_enc(float s) { return (ssq_t)(s * 1024.0f + 0.5f); }
__device__ __forceinline__ float ssq_dec(ssq_t v) { return (float)v * (1.0f / 1024.0f); }

constexpr int MROWS = 32768, DM = 1024, SEQ = 4096, NPROJ = 3584, NINP = 3840, DFF = 4096, HLD = 4160;
constexpr int LDS_BYTES = 163840;
constexpr float EPS = 1e-6f;

constexpr size_t WS_WIN = 0;
constexpr size_t WS_WOUT = WS_WIN + (size_t)2 * NINP * DM * 2;
constexpr size_t WS_WFF1 = WS_WOUT + (size_t)2 * DM * DM * 2;
constexpr size_t WS_WFF2 = WS_WFF1 + (size_t)2 * DFF * DM * 2;
constexpr size_t WS_XB = WS_WFF2 + (size_t)2 * DM * DFF * 2;
constexpr size_t WS_G = WS_XB + (size_t)MROWS * DM * 2;
constexpr size_t WS_SSQ = WS_G + (size_t)MROWS * 16 * 4;
constexpr size_t WS_R1 = WS_SSQ + (size_t)5 * MROWS * 8;
constexpr size_t WS_BAR = WS_R1 + (size_t)MROWS * HLD * 2;
constexpr size_t WS_PBUF = WS_BAR + 16384;
constexpr size_t WS_SCAL = WS_PBUF + (size_t)4096 * 8192;
constexpr size_t WS_QKC = WS_SCAL + (size_t)4096 * 192 * 4;
constexpr size_t WS_END = WS_QKC + (size_t)MROWS * DM * 2;

struct Params {
    const float* x; const float* norm1_w; const float* w_in; const float* conv_w; const float* conv_b; const float* gate_b;
    const float* mnorm_w; const float* rpb; const float* w_out; const float* norm2_w; const float* w_ff1; const float* w_ff2; const float* fnorm_w;
    float* out; unsigned char* ws; int ph_lo, ph_hi;
};

typedef __bf16 bf16x2_t __attribute__((ext_vector_type(2)));
__device__ __forceinline__ unsigned cvt_pk_bf16(float lo, float hi) { bf16x2_t v; v[0] = (__bf16)lo; v[1] = (__bf16)hi; return __builtin_bit_cast(unsigned, v); }
__device__ __forceinline__ int opaque_tid() { int t = threadIdx.x; asm volatile("" : "+v"(t)); return t; }
__device__ __forceinline__ float bf_lo(unsigned w) { return __uint_as_float(w << 16); }
__device__ __forceinline__ float bf_hi(unsigned w) { return __uint_as_float(w & 0xffff0000u); }
__device__ __forceinline__ s16x4 tr_read(LAS unsigned char* p) { return __builtin_amdgcn_ds_read_tr16_b64_v4i16((LAS s16x4*)p); }
__device__ __forceinline__ bf16x8 cat4(s16x4 a, s16x4 b) { bf16x8 r; r[0] = a[0]; r[1] = a[1]; r[2] = a[2]; r[3] = a[3]; r[4] = b[0]; r[5] = b[1]; r[6] = b[2]; r[7] = b[3]; return r; }
#define LDS_BARRIER() do { asm volatile("s_waitcnt lgkmcnt(0)" ::: "memory"); __builtin_amdgcn_s_barrier(); asm volatile("" ::: "memory"); } while (0)
__device__ __forceinline__ f32x4 mfma16(bf16x8 a, bf16x8 b, f32x4 c) { return __builtin_amdgcn_mfma_f32_16x16x32_bf16(a, b, c, 0, 0, 0); }


#define XB_TMO      128
#define XB_XCNT(j)  (256  + 64 * (j))
#define XB_XSUB(j)  (1280 + 64 * (j))
#define XB_XGEN(j)  (2304 + 64 * (j))
#define XB_TOP      3328
#define XB_TOPGEN   3392
#define XCD_BAR_WORDS 3456
#define XB_SPIN_CAP (1u << 22)
__device__ __forceinline__ unsigned xb_ld(unsigned* p)              { return __hip_atomic_load(p, __ATOMIC_RELAXED, __HIP_MEMORY_SCOPE_AGENT); }
__device__ __forceinline__ unsigned xb_add(unsigned* p, unsigned v) { return __hip_atomic_fetch_add(p, v, __ATOMIC_RELAXED, __HIP_MEMORY_SCOPE_AGENT); }
__device__ __forceinline__ unsigned xb_xcc_id() { return (unsigned)__builtin_amdgcn_s_getreg((3 << 11) | 20) & 0xFu; }
#define XB_SPIN(cond, bar) do { unsigned _sp = 0; while (cond) { __builtin_amdgcn_s_sleep(1); \
    if ((++_sp & 255u) == 0u) { if (xb_ld(&(bar)[XB_TMO])) break; if (_sp > XB_SPIN_CAP) { atomicAdd(&(bar)[XB_TMO], 1u); break; } } } } while (0)
struct XcdBarrier { unsigned* bar; unsigned x; volatile LAS unsigned* st; };
__device__ __forceinline__ XcdBarrier xcd_barrier_post(unsigned* bar, volatile LAS unsigned* st) {
    XcdBarrier b; b.bar = bar; b.x = xb_xcc_id(); b.st = st;
    if (threadIdx.x == 0) (void)xb_add(&bar[XB_XCNT(b.x)], 1u);
    return b;
}
__device__ __forceinline__ void xcd_barrier_complete(unsigned* bar, unsigned x, unsigned& nloc, unsigned& nx) {
    const unsigned G = gridDim.x * gridDim.y * gridDim.z;
    unsigned sum, cnt, mine, sp = 0u;
    for (;;) {
        sum = 0u; cnt = 0u; mine = 0u;
#pragma unroll
        for (unsigned j = 0; j < 16; ++j) { const unsigned c = xb_ld(&bar[XB_XCNT(j)]); sum += c; cnt += (c > 0u) ? 1u : 0u; mine = (j == x) ? c : mine; }
        if (sum == G) break;
        __builtin_amdgcn_s_sleep(1);
        if ((++sp & 255u) == 0u) { if (xb_ld(&bar[XB_TMO])) break; if (sp > XB_SPIN_CAP) { atomicAdd(&bar[XB_TMO], 1u); break; } }
    }
    nloc = mine > 0u ? mine : 1u; nx = cnt > 0u ? cnt : 1u;
}
__device__ __forceinline__ void xcd_barrier(const XcdBarrier& b) {
    asm volatile("s_waitcnt vmcnt(0)" ::: "memory");
    __syncthreads();
    if (threadIdx.x == 0) {
        unsigned* bar = b.bar;
        __builtin_amdgcn_s_waitcnt(0);
        unsigned nloc = b.st[0], nx = b.st[1];
        if (nloc == 0u) { xcd_barrier_complete(bar, b.x, nloc, nx); b.st[0] = nloc; b.st[1] = nx; }
        const unsigned old = xb_add(&bar[XB_XSUB(b.x)], 1u);
        const unsigned gen = old / nloc;
        if (old + 1u == (gen + 1u) * nloc) {
            __builtin_amdgcn_fence(__ATOMIC_RELEASE, "agent");
            asm volatile("s_waitcnt vmcnt(0)" ::: "memory");
            const unsigned og = xb_add(&bar[XB_TOP], 1u);
            const unsigned tg = og / nx;
            if (og + 1u == (tg + 1u) * nx) xb_add(&bar[XB_TOPGEN], 1u);
            else XB_SPIN(xb_ld(&bar[XB_TOPGEN]) == tg, bar);
            __builtin_amdgcn_fence(__ATOMIC_ACQUIRE, "agent");
            xb_add(&bar[XB_XGEN(b.x)], 1u);
            asm volatile("s_waitcnt vmcnt(0)" ::: "memory");
        } else {
            XB_SPIN(xb_ld(&bar[XB_XGEN(b.x)]) == gen, bar);
            __builtin_amdgcn_fence(__ATOMIC_ACQUIRE, "agent");
            asm volatile("s_waitcnt vmcnt(0)" ::: "memory");
        }
    }
    __syncthreads();
}

namespace pg8 {
constexpr int BM = 256, BK = 64, HALF = 128, HTB = HALF * BK * 2, STAGE_BYTES = 8 * HTB, NXCD = 8, WGM = 8;
__device__ __forceinline__ int lds_byte(int r, int c) { const int st = (r >> 4) * 2 + (c >> 5), rr = r & 15, cc = c & 31, ob = rr * 64 + cc * 2; return st * 1024 + (ob ^ (((ob >> 9) & 1) << 5)); }
__device__ __forceinline__ void stage_rc(int b, int& R, int& C) { const int st = b / 1024, sb = b % 1024, swz = sb ^ (((sb >> 9) & 1) << 5); R = (st >> 1) * 16 + swz / 64; C = (st & 1) * 32 + (swz % 64) / 2; }
__device__ __forceinline__ int perm32(int rho) { const int n = rho >> 4, i = rho & 15; return 8 * (i >> 2) + 4 * n + (i & 3); }
struct Unit { int pm, pn; };
struct Gemm { const bf16_t* A; const bf16_t* Bt; int M, N, K, lda; };
struct StaticOrder {
    int nM, nN, nwg, G, c;
    __device__ void init(int M, int N, int G_, int c_) { nM = M / BM; nN = N / BM; nwg = nM * nN; G = G_; c = c_; }
    __device__ bool next(int i, Unit& u) const {
        const long L = (long)i * G + c; if (L >= nwg) return false;
        int wgid = (int)L; { const int q = nwg / NXCD, r = nwg % NXCD, xcd = wgid % NXCD, off = wgid / NXCD; wgid = (xcd < r ? xcd * (q + 1) : r * (q + 1) + (xcd - r) * q) + off; }
        const int nig = WGM * nN, gid = wgid / nig, fm = gid * WGM, gsz = (nM - fm) < WGM ? (nM - fm) : WGM;
        u.pm = fm + ((wgid % nig) % gsz); u.pn = (wgid % nig) / gsz; return true;
    }
};

struct EpiProj {
    bf16_t* P; float* G; const ssq_t* ssq;
    static constexpr bool HAS_PRE = true;
    __device__ __forceinline__ void pre(const Unit& u, int wr, int fr, ssq_t (&pv)[8]) const {
        const int row0 = u.pm * BM + wr * 64 + fr;
#pragma unroll
        for (int ai = 0; ai < 2; ++ai)
#pragma unroll
            for (int m = 0; m < 4; ++m) pv[ai * 4 + m] = ssq[row0 + ai * HALF + m * 16];
    }
    __device__ __forceinline__ void operator()(const f32x4 (&acc)[2][2][4][2], const Unit& u, int wr, int wc, int fr, int fq, const ssq_t (&pv)[8]) const {
        const int row0 = u.pm * BM + wr * 64 + fr;
#pragma unroll
        for (int ai = 0; ai < 2; ++ai)
#pragma unroll
            for (int m = 0; m < 4; ++m) {
                const int row = row0 + ai * HALF + m * 16;
                const float rs = rsqrtf(ssq_dec(pv[ai * 4 + m]) * (1.0f / DM) + EPS);
                bf16_t* rowp = P + (size_t)row * NPROJ + u.pn * BM + wc * 32 + 8 * fq;
#pragma unroll
                for (int bj = 0; bj < 2; ++bj) { const f32x4 v0 = acc[ai][bj][m][0] * rs, v1 = acc[ai][bj][m][1] * rs;
                    u32x4 w; w.x = cvt_pk_bf16(v0[0], v0[1]); w.y = cvt_pk_bf16(v0[2], v0[3]); w.z = cvt_pk_bf16(v1[0], v1[1]); w.w = cvt_pk_bf16(v1[2], v1[3]);
                    *(u32x4*)(rowp + bj * HALF) = w; }
            }
    }
};
struct EpiResid { static constexpr bool INPLACE = true;
    const float* XinF; const bf16_t* XinB; float* XoutF; bf16_t* XB; ssq_t* ssq;
    static constexpr bool HAS_PRE = false;
    __device__ __forceinline__ void pre(const Unit&, int, int, ssq_t (&)[8]) const {}
    __device__ __forceinline__ void operator()(const f32x4 (&acc)[2][2][4][2], const Unit& u, int wr, int wc, int fr, int fq, const ssq_t (&)[8]) const {
        const int row0 = u.pm * BM + wr * 64 + fr, col0 = u.pn * BM + wc * 32 + 8 * fq;
#pragma unroll
        for (int ai = 0; ai < 2; ++ai) {
            f32x4 xo[4][2][2];
            if (XinF) {
#pragma unroll
                for (int m = 0; m < 4; ++m)
#pragma unroll
                    for (int bj = 0; bj < 2; ++bj) { const size_t off = (size_t)(row0 + ai * HALF + m * 16) * DM + col0 + bj * HALF; xo[m][bj][0] = *(const f32x4*)(XinF + off); xo[m][bj][1] = *(const f32x4*)(XinF + off + 4); }
            } else {
                u32x4 xb[4][2];
#pragma unroll
                for (int m = 0; m < 4; ++m)
#pragma unroll
                    for (int bj = 0; bj < 2; ++bj) xb[m][bj] = *(const u32x4*)(XinB + (size_t)(row0 + ai * HALF + m * 16) * DM + col0 + bj * HALF);
#pragma unroll
                for (int m = 0; m < 4; ++m)
#pragma unroll
                    for (int bj = 0; bj < 2; ++bj) { const u32x4 t = xb[m][bj]; xo[m][bj][0] = (f32x4){bf_lo(t.x), bf_hi(t.x), bf_lo(t.y), bf_hi(t.y)}; xo[m][bj][1] = (f32x4){bf_lo(t.z), bf_hi(t.z), bf_lo(t.w), bf_hi(t.w)}; }
            }
#pragma unroll
            for (int m = 0; m < 4; ++m) {
                const int row = row0 + ai * HALF + m * 16; float s = 0.f;
#pragma unroll
                for (int bj = 0; bj < 2; ++bj) { const size_t off = (size_t)row * DM + col0 + bj * HALF;
                    const f32x4 v0 = xo[m][bj][0] + acc[ai][bj][m][0], v1 = xo[m][bj][1] + acc[ai][bj][m][1];
                    if (XoutF) { *(f32x4*)(XoutF + off) = v0; *(f32x4*)(XoutF + off + 4) = v1; }
                    if (XB) { u32x4 w; w.x = cvt_pk_bf16(v0[0], v0[1]); w.y = cvt_pk_bf16(v0[2], v0[3]); w.z = cvt_pk_bf16(v1[0], v1[1]); w.w = cvt_pk_bf16(v1[2], v1[3]);
                        *(u32x4*)(XB + off) = w; }
                    s += (v0[0] * v0[0] + v0[1] * v0[1]) + (v0[2] * v0[2] + v0[3] * v0[3]) + (v1[0] * v1[0] + v1[1] * v1[1]) + (v1[2] * v1[2] + v1[3] * v1[3]); }
                s += __shfl_xor(s, 16); s += __shfl_xor(s, 32);
                if (fq == 0) atomicAdd(ssq + row, ssq_enc(s));
            }
        }
    }
};
struct EpiFF1 {
    bf16_t* H; const ssq_t* ssq;
    static constexpr bool HAS_PRE = true;
    __device__ __forceinline__ void pre(const Unit& u, int wr, int fr, ssq_t (&pv)[8]) const {
        const int row0 = u.pm * BM + wr * 64 + fr;
#pragma unroll
        for (int ai = 0; ai < 2; ++ai)
#pragma unroll
            for (int m = 0; m < 4; ++m) pv[ai * 4 + m] = ssq[row0 + ai * HALF + m * 16];
    }
    __device__ __forceinline__ void operator()(const f32x4 (&acc)[2][2][4][2], const Unit& u, int wr, int wc, int fr, int fq, const ssq_t (&pv)[8]) const {
        const int row0 = u.pm * BM + wr * 64 + fr, col0 = u.pn * BM + wc * 32 + 8 * fq;
#pragma unroll
        for (int ai = 0; ai < 2; ++ai)
#pragma unroll
            for (int m = 0; m < 4; ++m) {
                const int row = row0 + ai * HALF + m * 16;
                const float rs = rsqrtf(ssq_dec(pv[ai * 4 + m]) * (1.0f / DM) + EPS);
                bf16_t* rowp = H + (size_t)row * HLD + col0;
#pragma unroll
                for (int bj = 0; bj < 2; ++bj) { f32x4 v0 = acc[ai][bj][m][0] * rs, v1 = acc[ai][bj][m][1] * rs;
#pragma unroll
                    for (int j = 0; j < 4; ++j) { const float a = fmaxf(v0[j], 0.f), b = fmaxf(v1[j], 0.f); v0[j] = a * a; v1[j] = b * b; }
                    u32x4 w; w.x = cvt_pk_bf16(v0[0], v0[1]); w.y = cvt_pk_bf16(v0[2], v0[3]); w.z = cvt_pk_bf16(v1[0], v1[1]); w.w = cvt_pk_bf16(v1[2], v1[3]);
                    *(u32x4*)(rowp + bj * HALF) = w; }
            }
    }
};

template <class Epi>
__device__ __forceinline__ void gemm_phase(LAS unsigned char* lds, const Gemm g, const StaticOrder& S, const Epi& E) {
    const int tid = opaque_tid(), wid = __builtin_amdgcn_readfirstlane(tid >> 6), lane = tid & 63, wr = wid >> 2, wc = wid & 3, fr = lane & 15, fq = lane >> 4;
    const int K = g.K, nt = K / BK, lda = g.lda;
    unsigned voffA[2], voffB[2];
#pragma unroll
    for (int i = 0; i < 2; ++i) { int R, C; stage_rc(tid * 16 + i * 8192, R, C); const int Rb = (R & ~31) + perm32(R & 31);
        voffA[i] = (unsigned)(R * lda + C) * 2u; voffB[i] = (unsigned)(Rb * K + C) * 2u; }
    const size_t kstep = (size_t)(BK * 2);
    const size_t hstepA = (size_t)HALF * lda * 2, hstepB = (size_t)HALF * K * 2;
    const size_t tstepA = 2 * hstepA, tstepB = 2 * hstepB;
    const unsigned ldsw = (unsigned)wid * 1024u;
    const int aoff = lds_byte(wr * 64 + fr, fq * 8), boff = lds_byte(wc * 32 + fr, fq * 8);
#define PG8_SA(b, h) (((b) * 2 + (h)) * HTB)
#define PG8_SB(b, h) ((4 + (b) * 2 + (h)) * HTB)
#define PG8_STAGE(bufoff, gbase, voff) do { _Pragma("unroll") for (int _i = 0; _i < 2; ++_i) \
        __builtin_amdgcn_global_load_lds((const unsigned*)((const char*)(gbase) + (voff)[_i]), (LAS unsigned*)(lds + (bufoff) + ldsw + _i * 8192), 16, 0, 0); } while (0)
#define PG8_LDA(dst, b, h) do { _Pragma("unroll") for (int m = 0; m < 4; ++m) _Pragma("unroll") for (int k = 0; k < 2; ++k) dst[m][k] = *(const LAS bf16x8*)(lds + PG8_SA(b, h) + aoff + m * 2048 + k * 1024); } while (0)
#define PG8_LDB(dst, b, h) do { _Pragma("unroll") for (int n = 0; n < 2; ++n) _Pragma("unroll") for (int k = 0; k < 2; ++k) dst[n][k] = *(const LAS bf16x8*)(lds + PG8_SB(b, h) + boff + n * 2048 + k * 1024); } while (0)
#define PG8_MMA(ai, bj, At, Bt) do { __builtin_amdgcn_s_setprio(1); _Pragma("unroll") for (int m = 0; m < 4; ++m) _Pragma("unroll") for (int n = 0; n < 2; ++n) _Pragma("unroll") for (int k = 0; k < 2; ++k) \
        acc[ai][bj][m][n] = __builtin_amdgcn_mfma_f32_16x16x32_bf16(Bt[n][k], At[m][k], acc[ai][bj][m][n], 0, 0, 0); __builtin_amdgcn_s_setprio(0); } while (0)
#define PG8_WAIT_V(n) asm volatile("s_waitcnt vmcnt(" #n ")" ::: "memory")
#define PG8_WAIT_L(n) asm volatile("s_waitcnt lgkmcnt(" #n ")" ::: "memory")
#define PG8_BAR __builtin_amdgcn_s_barrier()
#define PG8_SCHED __builtin_amdgcn_sched_barrier(0)
    Unit cur, nxt; int ui = 0;
    if (!S.next(0, cur)) return;
    f32x4 acc[2][2][4][2];
#pragma unroll
    for (int a = 0; a < 2; ++a)
#pragma unroll
        for (int b = 0; b < 2; ++b)
#pragma unroll
            for (int m = 0; m < 4; ++m)
#pragma unroll
                for (int n = 0; n < 2; ++n) acc[a][b][m][n] = (f32x4){0.f, 0.f, 0.f, 0.f};
    bf16x8 At[4][2], B0[2][2], B1[2][2];
    ssq_t pv[8] = {0u, 0u, 0u, 0u, 0u, 0u, 0u, 0u};
    const char* cA = (const char*)g.A + (size_t)cur.pm * tstepA; const char* cB = (const char*)g.Bt + (size_t)cur.pn * tstepB;
    PG8_STAGE(PG8_SB(0, 0), cB, voffB); PG8_STAGE(PG8_SA(0, 0), cA, voffA); PG8_STAGE(PG8_SB(0, 1), cB + hstepB, voffB); PG8_STAGE(PG8_SA(0, 1), cA + hstepA, voffA);
    if (wr == 1) PG8_BAR;
    PG8_WAIT_V(4); PG8_BAR;
    PG8_STAGE(PG8_SB(1, 0), cB + kstep, voffB); PG8_STAGE(PG8_SA(1, 0), cA + kstep, voffA); PG8_STAGE(PG8_SB(1, 1), cB + hstepB + kstep, voffB);
    PG8_WAIT_V(6); PG8_BAR;
    for (;;) {
        const bool has_next = S.next(ui + 1, nxt);
        const char* nA = has_next ? (const char*)g.A + (size_t)nxt.pm * tstepA : cA; const char* nB = has_next ? (const char*)g.Bt + (size_t)nxt.pn * tstepB : cB;
        for (int t = 0; t < nt; t += 2) {
            const bool last = (t == nt - 2);
            const char* a1 = cA + (size_t)(t + 1) * kstep;
            const char* a2 = last ? nA : cA + (size_t)(t + 2) * kstep; const char* b2 = last ? nB : cB + (size_t)(t + 2) * kstep;
            const char* a3 = a2 + kstep; const char* b3 = b2 + kstep;
            if (Epi::HAS_PRE && last) E.pre(cur, wr, fr, pv);
            PG8_LDB(B0, 0, 0); PG8_SCHED; PG8_LDA(At, 0, 0); PG8_STAGE(PG8_SA(1, 1), a1 + hstepA, voffA);
            PG8_WAIT_L(8); PG8_BAR; PG8_WAIT_L(0); PG8_MMA(0, 0, At, B0); PG8_BAR; PG8_SCHED;
            PG8_LDB(B1, 0, 1); PG8_STAGE(PG8_SB(0, 0), b2, voffB);
            PG8_BAR; PG8_WAIT_L(0); PG8_MMA(0, 1, At, B1); PG8_BAR;
            PG8_LDA(At, 0, 1); PG8_STAGE(PG8_SA(0, 0), a2, voffA);
            PG8_BAR; PG8_WAIT_L(0); PG8_MMA(1, 0, At, B0); PG8_BAR; PG8_SCHED;
            PG8_STAGE(PG8_SB(0, 1), b2 + hstepB, voffB);
            PG8_WAIT_V(6); PG8_BAR; PG8_MMA(1, 1, At, B1); PG8_BAR;
            PG8_LDB(B0, 1, 0); PG8_SCHED; PG8_LDA(At, 1, 0); PG8_STAGE(PG8_SA(0, 1), a2 + hstepA, voffA);
            PG8_WAIT_L(8); PG8_BAR; PG8_WAIT_L(0); PG8_MMA(0, 0, At, B0); PG8_BAR; PG8_SCHED;
            PG8_LDB(B1, 1, 1); PG8_STAGE(PG8_SB(1, 0), b3, voffB);
            PG8_BAR; PG8_WAIT_L(0); PG8_MMA(0, 1, At, B1); PG8_BAR;
            PG8_LDA(At, 1, 1); PG8_STAGE(PG8_SA(1, 0), a3, voffA);
            PG8_BAR; PG8_WAIT_L(0); PG8_MMA(1, 0, At, B0); PG8_BAR; PG8_SCHED;
            PG8_STAGE(PG8_SB(1, 1), b3 + hstepB, voffB);
            PG8_WAIT_V(6); PG8_BAR; PG8_MMA(1, 1, At, B1); PG8_BAR;
        }
        E(acc, cur, wr, wc, fr, fq, pv);
        if (!has_next) break;
#pragma unroll
        for (int a = 0; a < 2; ++a)
#pragma unroll
            for (int b = 0; b < 2; ++b)
#pragma unroll
                for (int m = 0; m < 4; ++m)
#pragma unroll
                    for (int n = 0; n < 2; ++n) acc[a][b][m][n] = (f32x4){0.f, 0.f, 0.f, 0.f};
        cur = nxt; cA = nA; cB = nB; ++ui;
    }
    PG8_WAIT_V(0);
    if (wr == 0) PG8_BAR;
    PG8_BAR;
#undef PG8_SA
#undef PG8_SB
#undef PG8_STAGE
#undef PG8_LDA
#undef PG8_LDB
#undef PG8_MMA
#undef PG8_WAIT_V
#undef PG8_WAIT_L
#undef PG8_BAR
#undef PG8_SCHED
}
}

struct WtDesc { const float* src; const float* scale; bf16_t* dst; int ldsrc, K, kt, nt, nsrc0, nvalid; };
__device__ __forceinline__ WtDesc wt_desc(const Params& p, int t) {
    WtDesc d; unsigned char* ws = p.ws;
    const int l = t / 3264; int r = t % 3264;
    if (r < 960) { d.kt = r / 60; d.nt = r % 60; d.src = p.w_in + (size_t)l * DM * 3600; d.ldsrc = 3600; d.scale = p.norm1_w + l * DM; d.dst = (bf16_t*)(ws + WS_WIN) + (size_t)l * NINP * DM; d.K = DM;
        const int n0 = d.nt * 64; if (n0 < 2048) { d.nsrc0 = n0; d.nvalid = 64; } else if (n0 < 3584) { d.nsrc0 = n0 + 16; d.nvalid = 64; } else if (n0 == 3584) { d.nsrc0 = 2048; d.nvalid = 16; } else { d.nsrc0 = 0; d.nvalid = 0; } }
    else if (r < 1216) { r -= 960; d.kt = r / 16; d.nt = r % 16; d.src = p.w_out + (size_t)l * DM * DM; d.ldsrc = DM; d.scale = nullptr; d.dst = (bf16_t*)(ws + WS_WOUT) + (size_t)l * DM * DM; d.K = DM; d.nsrc0 = d.nt * 64; d.nvalid = 64; }
    else if (r < 2240) { r -= 1216; d.kt = r / 64; d.nt = r % 64; d.src = p.w_ff1 + (size_t)l * DM * DFF; d.ldsrc = DFF; d.scale = p.norm2_w + l * DM; d.dst = (bf16_t*)(ws + WS_WFF1) + (size_t)l * DFF * DM; d.K = DM; d.nsrc0 = d.nt * 64; d.nvalid = 64; }
    else { r -= 2240; d.kt = r / 16; d.nt = r % 16; d.src = p.w_ff2 + (size_t)l * DFF * DM; d.ldsrc = DM; d.scale = nullptr; d.dst = (bf16_t*)(ws + WS_WFF2) + (size_t)l * DM * DFF; d.K = DFF; d.nsrc0 = d.nt * 64; d.nvalid = 64; }
    return d;
}
__device__ __forceinline__ void prep_phase(const Params& p, LAS unsigned char* lds) {
    const int tid = opaque_tid();
    unsigned char* ws = p.ws;
    constexpr int NT = 4;
    for (int t = blockIdx.x; t < 6528; t += NT * gridDim.x) {
        WtDesc d[NT]; f32x4 v[NT][2]; float sc[NT][2]; bool has[NT];
#pragma unroll
        for (int q = 0; q < NT; ++q) { const int tq = t + q * gridDim.x; has[q] = tq < 6528; d[q] = wt_desc(p, has[q] ? tq : t);
#pragma unroll
            for (int it = 0; it < 2; ++it) { const int kk = (tid >> 4) + 32 * it, n4 = (tid & 15) * 4;
                v[q][it] = (f32x4){0.f, 0.f, 0.f, 0.f};
                if (n4 < d[q].nvalid) v[q][it] = __builtin_nontemporal_load((const f32x4*)(d[q].src + (size_t)(d[q].kt * 64 + kk) * d[q].ldsrc + d[q].nsrc0 + n4));
                sc[q][it] = d[q].scale ? d[q].scale[d[q].kt * 64 + kk] : 1.0f; } }
#pragma unroll
        for (int q = 0; q < NT; ++q) { LAS float* T = (LAS float*)lds + q * 4160;
#pragma unroll
            for (int it = 0; it < 2; ++it) { const int kk = (tid >> 4) + 32 * it, n4 = (tid & 15) * 4;
#pragma unroll
                for (int e = 0; e < 4; ++e) T[(n4 + e) * 65 + kk] = v[q][it][e] * sc[q][it]; } }
        __syncthreads();
#pragma unroll
        for (int q = 0; q < NT; ++q) if (has[q]) { const LAS float* T = (const LAS float*)lds + q * 4160; const int n = tid >> 3, k8 = (tid & 7) * 8; float f[8];
#pragma unroll
            for (int e = 0; e < 8; ++e) f[e] = T[n * 65 + k8 + e];
            u32x4 w; w.x = cvt_pk_bf16(f[0], f[1]); w.y = cvt_pk_bf16(f[2], f[3]); w.z = cvt_pk_bf16(f[4], f[5]); w.w = cvt_pk_bf16(f[6], f[7]);
            *(u32x4*)(d[q].dst + (size_t)(d[q].nt * 64 + n) * d[q].K + d[q].kt * 64 + k8) = w; }
        __syncthreads();
    }
    const int wave = tid >> 6, lane = tid & 63;
    bf16_t* XB = (bf16_t*)(ws + WS_XB); ssq_t* ssq = (ssq_t*)(ws + WS_SSQ);
    for (int t = blockIdx.x; t < MROWS / 16; t += gridDim.x) {
        f32x4 v[2][4];
#pragma unroll
        for (int q = 0; q < 2; ++q) { const f32x4* xr = (const f32x4*)(p.x + (size_t)(t * 16 + wave * 2 + q) * DM);
#pragma unroll
            for (int it = 0; it < 4; ++it) v[q][it] = __builtin_nontemporal_load(xr + it * 64 + lane); }
#pragma unroll
        for (int q = 0; q < 2; ++q) { const int row = t * 16 + wave * 2 + q; float s = 0.f;
#pragma unroll
            for (int it = 0; it < 4; ++it) { const f32x4 x = v[q][it]; s += (x[0] * x[0] + x[1] * x[1]) + (x[2] * x[2] + x[3] * x[3]);
                u32x2 w; w.x = cvt_pk_bf16(x[0], x[1]); w.y = cvt_pk_bf16(x[2], x[3]); *(u32x2*)(XB + (size_t)row * DM + (it * 64 + lane) * 4) = w; }
#pragma unroll
            for (int o = 32; o >= 1; o >>= 1) s += __shfl_xor(s, o);
            if (lane == 0) ssq[row] = ssq_enc(s); }
    }
    for (int i = blockIdx.x * 512 + tid; i < 4 * MROWS; i += gridDim.x * 512) ssq[MROWS + i] = 0u;
}

__device__ __forceinline__ void conv_phase(const Params& p, int l) {
    const int tid = opaque_tid(), cgp = tid & 127, rg = tid >> 7, c0 = cgp * 8;
    const bf16_t* PROJ = (const bf16_t*)(p.ws + WS_R1); bf16_t* QKC = (bf16_t*)(p.ws + WS_QKC);
    const float* cw = p.conv_w + (size_t)l * 3 * 1024; const float* cb = p.conv_b + (size_t)l * 1024;
    float w0[8], w1[8], w2[8], bb[8];
#pragma unroll
    for (int e = 0; e < 8; ++e) { w0[e] = cw[c0 + e]; w1[e] = cw[1024 + c0 + e]; w2[e] = cw[2048 + c0 + e]; bb[e] = cb[c0 + e]; }
    const float ksc = (c0 >= 512) ? 0.08838834764831845f : 1.0f;
    for (int t = blockIdx.x; t < MROWS / 16; t += gridDim.x) {
        const int r0 = t * 16 + rg * 4;
        u32x4 rw[6];
#pragma unroll
        for (int q = 0; q < 6; ++q) {
            const bool ok = !((q == 0 && (r0 & (SEQ - 1)) == 0) || (q == 5 && ((r0 + 3) & (SEQ - 1)) == SEQ - 1));
            rw[q] = (u32x4){0u, 0u, 0u, 0u};
            if (ok) rw[q] = *(const u32x4*)(PROJ + (size_t)(r0 - 1 + q) * NPROJ + c0);
        }
#pragma unroll
        for (int i = 0; i < 4; ++i) {
            float y[8];
#pragma unroll
            for (int e2 = 0; e2 < 4; ++e2) {
                const float a0 = bf_lo(rw[i][e2]), a1 = bf_hi(rw[i][e2]), b0 = bf_lo(rw[i + 1][e2]), b1 = bf_hi(rw[i + 1][e2]), c0f = bf_lo(rw[i + 2][e2]), c1f = bf_hi(rw[i + 2][e2]);
                y[2 * e2] = w0[2 * e2] * a0 + w1[2 * e2] * b0 + w2[2 * e2] * c0f + bb[2 * e2];
                y[2 * e2 + 1] = w0[2 * e2 + 1] * a1 + w1[2 * e2 + 1] * b1 + w2[2 * e2 + 1] * c1f + bb[2 * e2 + 1];
            }
#pragma unroll
            for (int e = 0; e < 8; ++e) y[e] = y[e] * __builtin_amdgcn_rcpf(1.0f + __expf(-y[e])) * ksc;
            u32x4 w; w.x = cvt_pk_bf16(y[0], y[1]); w.y = cvt_pk_bf16(y[2], y[3]); w.z = cvt_pk_bf16(y[4], y[5]); w.w = cvt_pk_bf16(y[6], y[7]);
            *(u32x4*)(QKC + (size_t)(r0 + i) * DM + c0) = w;
        }
    }
}

constexpr int NA_VSTR = 144;
constexpr int NA_KR = 0, NA_VR = 8 * 64 * 128, NA_MRG = NA_VR + 8 * 64 * NA_VSTR, NA_BT = NA_MRG + 4 * 18 * 64 * 4, NA_END = NA_BT + 15 * 32 * 4;
static_assert(NA_END <= LDS_BYTES - 16, "NA LDS");
__device__ __forceinline__ void na_phase(const Params& p, int l, LAS unsigned char* lds, bool probe = false) {
    const int tid = opaque_tid(), w = __builtin_amdgcn_readfirstlane(tid >> 6), lane = tid & 63, g = lane >> 4, c = lane & 15;
    bf16_t* PROJ = (bf16_t*)(p.ws + WS_R1);
    const int half = w >> 2, qt = w & 3, c0 = qt * 16;
    const int wsn = (c0 - 8 < 0) ? 0 : ((c0 - 8 > 32) ? 32 : c0 - 8);
    const int qc = c0 + c;
    const int cs = (qc - 8 < 0) ? 0 : ((qc - 8 > 48) ? 48 : qc - 8);
    int rc[2][4];
#pragma unroll
    for (int kt = 0; kt < 2; ++kt)
#pragma unroll
        for (int i = 0; i < 4; ++i) { const int kc = wsn + kt * 16 + 4 * g + i; rc[kt][i] = ((kc >= cs) && (kc < cs + 16)) ? (kc - qc + 15) : 31; }
    const int skey = tid >> 3, sch = tid & 7;
    const int skoff = skey * 128 + ((sch ^ (skey & 7)) * 16), svoff = skey * NA_VSTR + sch * 16;
    LAS float* bt = (LAS float*)(lds + NA_BT);
    for (int task = blockIdx.x; task < 256; task += gridDim.x) {
        const int head = task & 7, strip = (task >> 3) & 3, b = task >> 5;
        const int r0 = strip * 16;
        const bf16_t* kvbase = PROJ + ((size_t)b * SEQ + skey) * NPROJ + 2560 + head * 64 + sch * 8;
        int rs = (r0 - 4 < 0) ? 0 : ((r0 - 4 > 56) ? 56 : r0 - 4);
        __syncthreads();
        { u32x4 kk8[8], vv8[8];
#pragma unroll
          for (int j = 0; j < 8; ++j) { const bf16_t* src = kvbase + (size_t)(rs + j) * 64 * NPROJ; kk8[j] = *(const u32x4*)src; vv8[j] = *(const u32x4*)(src + 512); }
#pragma unroll
          for (int j = 0; j < 8; ++j) { const int slot = (rs + j) & 7; *(LAS u32x4*)(lds + NA_KR + slot * 8192 + skoff) = kk8[j]; *(LAS u32x4*)(lds + NA_VR + slot * 9216 + svoff) = vv8[j]; } }
        if (tid < 480) { const int br_ = tid >> 5, bc_ = tid & 31; bt[tid] = (bc_ < 31) ? p.rpb[(size_t)l * 8 * 465 + (size_t)head * 465 + br_ * 31 + bc_] * 1.4426950408889634f : -1e30f; }
        bf16x8 qf[2];
        { const size_t qtok = (size_t)b * SEQ + (size_t)r0 * 64 + c0 + c;
#pragma unroll
          for (int kk = 0; kk < 2; ++kk) qf[kk] = *(const bf16x8*)(PROJ + qtok * NPROJ + 2048 + head * 64 + kk * 32 + g * 8); }
        LDS_BARRIER();
        float breg[4][2][4]; int boff = 0x7fffffff;
#pragma unroll 1
        for (int ri = 0; ri < 16; ++ri) {
            const int r = r0 + ri;
            if (rs - r != boff) { boff = rs - r;
#pragma unroll
                for (int j = 0; j < 4; ++j)
#pragma unroll
                    for (int kt = 0; kt < 2; ++kt)
#pragma unroll
                        for (int i = 0; i < 4; ++i) breg[j][kt][i] = bt[(boff + 4 * half + j + 7) * 32 + rc[kt][i]]; }
            const size_t qtok = (size_t)b * SEQ + (size_t)r * 64 + c0 + c;
            const int rn = (ri < 15) ? r + 1 : r;
            const int rsn = (rn - 4 < 0) ? 0 : ((rn - 4 > 56) ? 56 : rn - 4);
            const bool slide = rsn != rs;
            const bf16_t* nsrc = kvbase + (size_t)(rsn + 7) * 64 * NPROJ;
            const u32x4 nk = *(const u32x4*)nsrc, nv = *(const u32x4*)(nsrc + 512);
            bf16x8 qfn[2];
            { const size_t qtokn = (size_t)b * SEQ + (size_t)rn * 64 + c0 + c;
#pragma unroll
              for (int kk = 0; kk < 2; ++kk) qfn[kk] = *(const bf16x8*)(PROJ + qtokn * NPROJ + 2048 + head * 64 + kk * 32 + g * 8); }
            __builtin_amdgcn_sched_barrier(0);
            f32x4 sc[4][2];
#pragma unroll
            for (int j = 0; j < 4; ++j) { const int slot = (rs + 4 * half + j) & 7;
#pragma unroll
                for (int kt = 0; kt < 2; ++kt) { f32x4 a = (f32x4){0.f, 0.f, 0.f, 0.f}; const int key = wsn + kt * 16 + c;
#pragma unroll
                    for (int kk = 0; kk < 2; ++kk) { const bf16x8 kfr = *(const LAS bf16x8*)(lds + NA_KR + slot * 8192 + key * 128 + (((kk * 4 + g) ^ (key & 7)) * 16)); a = mfma16(kfr, qf[kk], a); }
                    sc[j][kt] = a; } }
            float mrun = -1e30f;
#pragma unroll
            for (int j = 0; j < 4; ++j) {
#pragma unroll
                for (int kt = 0; kt < 2; ++kt)
#pragma unroll
                    for (int i = 0; i < 4; ++i) { const float sv = sc[j][kt][i] * 0.18033688011112042f + breg[j][kt][i]; sc[j][kt][i] = sv; mrun = fmaxf(mrun, sv); } }
            mrun = fmaxf(mrun, __shfl_xor(mrun, 16)); mrun = fmaxf(mrun, __shfl_xor(mrun, 32));
            float lrun = 0.f;
#pragma unroll
            for (int j = 0; j < 4; ++j)
#pragma unroll
                for (int kt = 0; kt < 2; ++kt)
#pragma unroll
                    for (int i = 0; i < 4; ++i) { const float pv = __builtin_amdgcn_exp2f(sc[j][kt][i] - mrun); sc[j][kt][i] = pv; lrun += pv; }
            lrun += __shfl_xor(lrun, 16); lrun += __shfl_xor(lrun, 32);
            f32x4 O[4];
#pragma unroll
            for (int dt = 0; dt < 4; ++dt) O[dt] = (f32x4){0.f, 0.f, 0.f, 0.f};
#pragma unroll
            for (int j = 0; j < 4; ++j) { const int slot = (rs + 4 * half + j) & 7;
                u32x4 pw; pw.x = cvt_pk_bf16(sc[j][0][0], sc[j][0][1]); pw.y = cvt_pk_bf16(sc[j][0][2], sc[j][0][3]); pw.z = cvt_pk_bf16(sc[j][1][0], sc[j][1][1]); pw.w = cvt_pk_bf16(sc[j][1][2], sc[j][1][3]);
                const bf16x8 pf = __builtin_bit_cast(bf16x8, pw);
                LAS unsigned char* vb = lds + NA_VR + slot * 9216 + (wsn + 4 * g + (c >> 2)) * NA_VSTR + (c & 3) * 8;
#pragma unroll
                for (int dt = 0; dt < 4; ++dt) { const s16x4 t0 = tr_read(vb + dt * 32), t1 = tr_read(vb + 16 * NA_VSTR + dt * 32); O[dt] = mfma16(cat4(t0, t1), pf, O[dt]); }
            }
            LDS_BARRIER();
            LAS float* MRG = (LAS float*)(lds + NA_MRG) + qt * 18 * 64 + lane;
            if (half == 1) { MRG[0] = mrun; MRG[64] = lrun;
#pragma unroll
                for (int dt = 0; dt < 4; ++dt)
#pragma unroll
                    for (int i = 0; i < 4; ++i) MRG[(2 + dt * 4 + i) * 64] = O[dt][i]; }
            if (slide) { const int slot = (rsn + 7) & 7; *(LAS u32x4*)(lds + NA_KR + slot * 8192 + skoff) = nk; *(LAS u32x4*)(lds + NA_VR + slot * 9216 + svoff) = nv; }
            LDS_BARRIER();
            if (half == 0) {
                const float m1 = MRG[0], l1 = MRG[64];
                const float m = fmaxf(mrun, m1), a0 = __builtin_amdgcn_exp2f(mrun - m), a1 = __builtin_amdgcn_exp2f(m1 - m);
                const float inv = __builtin_amdgcn_rcpf(lrun * a0 + l1 * a1);
#pragma unroll
                for (int dt = 0; dt < 4; ++dt) { f32x4 o;
#pragma unroll
                    for (int i = 0; i < 4; ++i) o[i] = (O[dt][i] * a0 + MRG[(2 + dt * 4 + i) * 64] * a1) * inv;
                    u32x2 wv; wv.x = cvt_pk_bf16(o[0], o[1]); wv.y = cvt_pk_bf16(o[2], o[3]);
                    if (probe) *(u32x2*)(PROJ + (size_t)MROWS * NPROJ + qtok * 512 + head * 64 + dt * 16 + 4 * g) = wv; else *(u32x2*)(PROJ + qtok * NPROJ + 2048 + head * 64 + dt * 16 + 4 * g) = wv; }
            }
            rs = rsn; qf[0] = qfn[0]; qf[1] = qfn[1];
        }
    }
    __syncthreads();
}

constexpr int ML_QSTR = 272, ML_VSTR = 112, ML_PSTR = 144, ML_SCB = 1536;
constexpr int ML_QS = 0, ML_KS = ML_QS + 2 * 64 * ML_QSTR, ML_VS = ML_KS + 2 * 64 * ML_QSTR, ML_VG = ML_VS + 2 * 64 * ML_VSTR, ML_PS = ML_VG + 2 * 64 * ML_VSTR,
              ML_CS = ML_PS + 2 * 64 * ML_PSTR, ML_SC = ML_CS + 2 * 48 * ML_QSTR, ML_END = ML_SC + 3 * ML_SCB;
static_assert(ML_END <= LDS_BYTES - 16, "mLSTM LDS");
#define ML_TOK(n, j) (tokb + (size_t)(dir ? (SEQ - 1 - ((n) * 64 + (j))) : ((n) * 64 + (j))))
__device__ __forceinline__ void mpre_phase(const Params& p, int l) {
    const int tid = opaque_tid(), w = tid >> 6, lane = tid & 63, g = lane >> 4, c = lane & 15;
    const bf16_t* QKC = (const bf16_t*)(p.ws + WS_QKC); const float* G = (const float*)(p.ws + WS_G); bf16_t* PBUF = (bf16_t*)(p.ws + WS_PBUF);
    for (int inst = blockIdx.x * 8 + w; inst < 4096; inst += gridDim.x * 8) {
        const int n = inst & 63, dir = (inst >> 6) & 1, h = (inst >> 7) & 3, b = inst >> 9;
        const size_t tokb = (size_t)b * SEQ;
        const size_t tk = ML_TOK(n, lane);
        const float ig = G[tk * 16 + (2 * dir) * 4 + h] + p.gate_b[l * 16 + (2 * dir) * 4 + h], fp = G[tk * 16 + (2 * dir + 1) * 4 + h] + p.gate_b[l * 16 + (2 * dir + 1) * 4 + h];
        bf16x8 kf[4][4], qf[4][4];
#pragma unroll
        for (int mt = 0; mt < 4; ++mt) { const size_t tkm = ML_TOK(n, 16 * mt + c);
#pragma unroll
            for (int kk = 0; kk < 4; ++kk) { kf[mt][kk] = *(const bf16x8*)(QKC + tkm * DM + 512 + h * 128 + kk * 32 + g * 8); qf[mt][kk] = *(const bf16x8*)(QKC + tkm * DM + h * 128 + kk * 32 + g * 8); } }
        float bcum = fminf(fp, 0.f) - __logf(1.0f + __expf(-fabsf(fp)));
#pragma unroll
        for (int o = 1; o < 64; o <<= 1) { const float t_ = __shfl_up(bcum, o); if (lane >= o) bcum += t_; }
        const float u = ig - bcum; float cm = u;
#pragma unroll
        for (int o = 1; o < 64; o <<= 1) { const float t_ = __shfl_up(cm, o); if (lane >= o) cm = fmaxf(cm, t_); }
        { float* sl = (float*)(p.ws + WS_SCAL) + (size_t)inst * 192; sl[lane] = bcum; sl[64 + lane] = u; sl[128 + lane] = cm; }
        bf16_t* pb = PBUF + (size_t)inst * 4096;
#pragma unroll
        for (int mt = 0; mt < 4; ++mt)
#pragma unroll
            for (int nt = 0; nt < 4; ++nt) { u32x2 pw = (u32x2){0u, 0u};
                if (mt <= nt) { f32x4 a = (f32x4){0.f, 0.f, 0.f, 0.f};
#pragma unroll
                    for (int kk = 0; kk < 4; ++kk) a = mfma16(kf[mt][kk], qf[nt][kk], a);
                    const float cmj = __shfl(cm, 16 * nt + c); float pv[4];
#pragma unroll
                    for (int i = 0; i < 4; ++i) { const int s_ = 16 * mt + 4 * g + i; const float us = __shfl(u, s_); pv[i] = (s_ <= 16 * nt + c) ? __expf(us - cmj) * a[i] : 0.f; }
                    pw.x = cvt_pk_bf16(pv[0], pv[1]); pw.y = cvt_pk_bf16(pv[2], pv[3]); }
                *(u32x2*)(pb + (16 * nt + c) * 64 + 16 * mt + 4 * g) = pw; }
    }
}

__device__ __forceinline__ void mlstm_phase(const Params& p, int l, LAS unsigned char* lds) {
    const int tid = opaque_tid(), w = __builtin_amdgcn_readfirstlane(tid >> 6), lane = tid & 63, g = lane >> 4, c = lane & 15;
    bf16_t* PROJ = (bf16_t*)(p.ws + WS_R1); const bf16_t* QKC = (const bf16_t*)(p.ws + WS_QKC); const float* G = (const float*)(p.ws + WS_G);
    const bf16_t* PBUF = (const bf16_t*)(p.ws + WS_PBUF);
    for (int task = blockIdx.x; task < 256; task += gridDim.x) {
        const int xq = task & 7, yq = task >> 3, vs = yq & 3, dir = (yq >> 2) & 1, bh = xq + 8 * (yq >> 3), h = bh & 3, b = bh >> 2;
        const size_t tokb = (size_t)b * SEQ;
        const bf16_t* pbase = PBUF + (size_t)(((b * 4 + h) * 2 + dir) * 64) * 4096 + (tid >> 3) * 64 + (tid & 7) * 8;
        const float gbi = p.gate_b[l * 16 + (2 * dir) * 4 + h], gbf = p.gate_b[l * 16 + (2 * dir + 1) * 4 + h];
        float mprev_chain = 0.f;
        __syncthreads();
        for (int i = tid; i < 48 * ML_QSTR / 4; i += 512) ((LAS unsigned*)(lds + ML_CS))[i] = 0u;
#define ML_GLOAD(n) do { const float* sl_ = scal + (size_t)(n) * 192; g_b = sl_[lane]; g_u = sl_[64 + lane]; g_cm = sl_[128 + lane]; } while (0)
#define ML_SCAN(sci) do { \
            const float Mj_ = fmaxf(mprev_chain, g_cm); \
            const float M63_ = __builtin_bit_cast(float, __builtin_amdgcn_readlane(__builtin_bit_cast(int, Mj_), 63)), tot_ = __builtin_bit_cast(float, __builtin_amdgcn_readlane(__builtin_bit_cast(int, g_b), 63)); \
            LAS float* sc_ = (LAS float*)(lds + ML_SC + (sci) * ML_SCB); \
            sc_[lane] = g_b; sc_[128 + lane] = Mj_; sc_[192 + lane] = __expf(g_u - M63_); sc_[320 + lane] = __expf(g_cm - Mj_); \
            if (lane == 0) { sc_[256] = __expf(mprev_chain - M63_); sc_[257] = mprev_chain; } \
            mprev_chain = tot_ + M63_; } while (0)
        const float* scal = (const float*)(p.ws + WS_SCAL) + (size_t)(((b * 4 + h) * 2 + dir) * 64) * 192;
        float g_b = 0.f, g_u = 0.f, g_cm = 0.f;
        if (w == 7) { ML_GLOAD(0); ML_SCAN(0); ML_GLOAD(1); ML_SCAN(1); }
        u32x4 qreg[1][2], kreg[1][2], vreg[1], preg[1];
        const long dtok = dir ? -1 : 1;
        const bf16_t* qp0 = QKC + ML_TOK(0, tid >> 4) * DM + h * 128 + (tid & 15) * 8;
        const bf16_t* vp = PROJ + ML_TOK(0, tid >> 2) * NPROJ + 1024 + h * 128 + vs * 32 + (tid & 3) * 8;
        const bf16_t* pp = pbase;
#define ML_LOAD(n, rs_) do { \
            qreg[rs_][0] = *(const u32x4*)(qp0); kreg[rs_][0] = *(const u32x4*)(qp0 + 512); \
            qreg[rs_][1] = *(const u32x4*)(qp0 + dtok * 32 * DM); kreg[rs_][1] = *(const u32x4*)(qp0 + dtok * 32 * DM + 512); \
            preg[rs_] = *(const u32x4*)(pp); \
            if (tid < 256) vreg[rs_] = *(const u32x4*)(vp); \
            qp0 += dtok * 64 * DM; vp += dtok * 64 * NPROJ; pp += 4096; } while (0)
#define ML_STORE(bufi, sci, rs_) do { \
            _Pragma("unroll") for (int it = 0; it < 2; ++it) { const int pc = it * 512 + tid, j = pc >> 4, part = pc & 15; \
                *(LAS u32x4*)(lds + ML_QS + (bufi) * 64 * ML_QSTR + j * ML_QSTR + part * 16) = qreg[rs_][it]; *(LAS u32x4*)(lds + ML_KS + (bufi) * 64 * ML_QSTR + j * ML_QSTR + part * 16) = kreg[rs_][it]; } \
            *(LAS u32x4*)(lds + ML_PS + (bufi) * 64 * ML_PSTR + (tid >> 3) * ML_PSTR + (tid & 7) * 16) = preg[rs_]; \
            const LAS float* scg_ = (const LAS float*)(lds + ML_SC + (sci) * ML_SCB + 192 * 4); \
            if (tid < 256) { const int j = tid >> 2, part = tid & 3; const float gj = scg_[j]; \
                *(LAS u32x4*)(lds + ML_VS + (bufi) * 64 * ML_VSTR + j * ML_VSTR + part * 16) = vreg[rs_]; u32x4 vg; \
                _Pragma("unroll") for (int e = 0; e < 4; ++e) vg[e] = cvt_pk_bf16(bf_lo(vreg[rs_][e]) * gj, bf_hi(vreg[rs_][e]) * gj); \
                *(LAS u32x4*)(lds + ML_VG + (bufi) * 64 * ML_VSTR + j * ML_VSTR + part * 16) = vg; } \
            else if (tid < 320) { const int j = tid - 256; const float gj = scg_[j]; \
                *(LAS u32x4*)(lds + ML_VS + (bufi) * 64 * ML_VSTR + j * ML_VSTR + 64) = (u32x4){0x3F80u, 0u, 0u, 0u}; *(LAS u32x4*)(lds + ML_VS + (bufi) * 64 * ML_VSTR + j * ML_VSTR + 80) = (u32x4){0u, 0u, 0u, 0u}; \
                *(LAS u32x4*)(lds + ML_VG + (bufi) * 64 * ML_VSTR + j * ML_VSTR + 64) = (u32x4){cvt_pk_bf16(gj, 0.f), 0u, 0u, 0u}; *(LAS u32x4*)(lds + ML_VG + (bufi) * 64 * ML_VSTR + j * ML_VSTR + 80) = (u32x4){0u, 0u, 0u, 0u}; } } while (0)
        ML_LOAD(0, 0);
        __syncthreads();
        ML_STORE(0, 0, 0);
        __syncthreads();
        f32x4 CT[2][3];
#pragma unroll
        for (int a = 0; a < 2; ++a)
#pragma unroll
            for (int v = 0; v < 3; ++v) CT[a][v] = (f32x4){0.f, 0.f, 0.f, 0.f};
        int s0 = 0, s1 = 1, s2 = 2;
        bf16_t* hp = PROJ + ML_TOK(0, 16 * (w & 3) + c) * NPROJ + dir * 512 + h * 128 + vs * 32 + 4 * g;
#define ML_STEP_BODY \
            LAS unsigned char* QS = lds + ML_QS + buf * 64 * ML_QSTR; LAS unsigned char* KS = lds + ML_KS + buf * 64 * ML_QSTR; \
            LAS unsigned char* VS = lds + ML_VS + buf * 64 * ML_VSTR; LAS unsigned char* VG = lds + ML_VG + buf * 64 * ML_VSTR; \
            LAS unsigned char* PS = lds + ML_PS + buf * 64 * ML_PSTR; LAS unsigned char* CS = lds + ML_CS + buf * 48 * ML_QSTR; LAS unsigned char* CSn = lds + ML_CS + nb * 48 * ML_QSTR; \
            const LAS float* sc = (const LAS float*)(lds + ML_SC + s0 * ML_SCB); \
            u32x2 hw[2] = {(u32x2){0u, 0u}, (u32x2){0u, 0u}}; \
            if (n + 1 < 64) ML_LOAD(n + 1, 0); \
            if (w == 7 && n + 2 < 64) ML_GLOAD(n + 2); \
            if (w < 4) { \
                const float mprev = sc[257]; \
                bf16x8 qa[4]; \
_Pragma("unroll") \
                for (int kk = 0; kk < 4; ++kk) qa[kk] = *(const LAS bf16x8*)(QS + (16 * w + c) * ML_QSTR + kk * 64 + g * 16); \
                bf16x8 pa[2]; \
_Pragma("unroll") \
                for (int kk = 0; kk < 2; ++kk) pa[kk] = *(const LAS bf16x8*)(PS + (16 * w + c) * ML_PSTR + kk * 64 + g * 16); \
                const int jj = 16 * w + c; const float Mj = sc[128 + jj]; \
                const float wi = __expf(mprev - Mj), em = __expf(-(sc[jj] + Mj)), rho = sc[320 + jj]; \
                f32x4 num[3]; \
_Pragma("unroll") \
                for (int vt = 0; vt < 3; ++vt) { f32x4 a = (f32x4){0.f, 0.f, 0.f, 0.f}, a2 = (f32x4){0.f, 0.f, 0.f, 0.f}; \
_Pragma("unroll") \
                    for (int kk = 0; kk < 4; ++kk) { const bf16x8 cf = *(const LAS bf16x8*)(CS + (16 * vt + c) * ML_QSTR + kk * 64 + g * 16); a = mfma16(cf, qa[kk], a); } \
_Pragma("unroll") \
                    for (int kk = 0; kk < 2; ++kk) { LAS unsigned char* vb = VS + (32 * kk + 8 * g + (c >> 2)) * ML_VSTR + vt * 32 + (c & 3) * 8; \
                        const s16x4 t0 = tr_read(vb), t1 = tr_read(vb + 4 * ML_VSTR); a2 = mfma16(cat4(t0, t1), pa[kk], a2); } \
                    num[vt] = a * wi + a2 * rho; } \
                const float den = __shfl(num[2][0], c); const float inv = __builtin_amdgcn_rcpf(fmaxf(fabsf(den), em)); \
_Pragma("unroll") \
                for (int vt = 0; vt < 2; ++vt) { const f32x4 o = num[vt] * inv; hw[vt].x = cvt_pk_bf16(o[0], o[1]); hw[vt].y = cvt_pk_bf16(o[2], o[3]); } \
            } else { \
                const int ww = w - 4; const float decay = sc[256]; \
_Pragma("unroll") \
                for (int a = 0; a < 2; ++a) \
_Pragma("unroll") \
                    for (int v = 0; v < 3; ++v) CT[a][v] = CT[a][v] * decay; \
_Pragma("unroll") \
                for (int kk = 0; kk < 2; ++kk) { bf16x8 af[2], bfr[3]; \
_Pragma("unroll") \
                    for (int a = 0; a < 2; ++a) { LAS unsigned char* kb = KS + (32 * kk + 8 * g + (c >> 2)) * ML_QSTR + (2 * ww + a) * 32 + (c & 3) * 8; af[a] = cat4(tr_read(kb), tr_read(kb + 4 * ML_QSTR)); } \
_Pragma("unroll") \
                    for (int v = 0; v < 3; ++v) { LAS unsigned char* vb = VG + (32 * kk + 8 * g + (c >> 2)) * ML_VSTR + v * 32 + (c & 3) * 8; bfr[v] = cat4(tr_read(vb), tr_read(vb + 4 * ML_VSTR)); } \
_Pragma("unroll") \
                    for (int a = 0; a < 2; ++a) \
_Pragma("unroll") \
                        for (int v = 0; v < 3; ++v) CT[a][v] = mfma16(af[a], bfr[v], CT[a][v]); } \
_Pragma("unroll") \
                for (int a = 0; a < 2; ++a) \
_Pragma("unroll") \
                    for (int v = 0; v < 3; ++v) { u32x2 cw; cw.x = cvt_pk_bf16(CT[a][v][0], CT[a][v][1]); cw.y = cvt_pk_bf16(CT[a][v][2], CT[a][v][3]); \
                        *(LAS u32x2*)(CSn + (16 * v + c) * ML_QSTR + (16 * (2 * ww + a) + 4 * g) * 2) = cw; } \
                if (w == 7 && n + 2 < 64) { ML_SCAN(s2); } \
            } \
            if (n + 1 < 64) ML_STORE(nb, s1, 0); \
            if (w < 4) { *(u32x2*)(hp) = hw[0]; *(u32x2*)(hp + 16) = hw[1]; } \
            LDS_BARRIER(); \
            { const int t_ = s0; s0 = s1; s1 = s2; s2 = t_; } \
            hp += dtok * 64 * NPROJ;
#pragma unroll 1
        for (int n2 = 0; n2 < 64; n2 += 2) {
            { constexpr int buf = 0, nb = 1; const int n = n2; ML_STEP_BODY }
            { constexpr int buf = 1, nb = 0; const int n = n2 + 1; ML_STEP_BODY }
        }
#undef ML_STEP_BODY
#undef ML_SCAN
#undef ML_GLOAD
#undef ML_LOAD
#undef ML_STORE
    }
}
#undef ML_TOK

__device__ __forceinline__ void combine_phase(const Params& p, int l) {
    const int tid = opaque_tid(), wave = tid >> 6, lane = tid & 63, col = lane * 8;
    bf16_t* PROJ = (bf16_t*)(p.ws + WS_R1);
    float nw[8];
#pragma unroll
    for (int e = 0; e < 8; ++e) nw[e] = p.mnorm_w[l * 512 + col + e];
    for (int t32 = blockIdx.x; t32 < MROWS / 32; t32 += gridDim.x) {
        u32x4 hf[4], hb[4], ov[4];
#pragma unroll
        for (int q = 0; q < 4; ++q) { const bf16_t* base = PROJ + (size_t)(t32 * 32 + wave * 4 + q) * NPROJ;
            hf[q] = *(const u32x4*)(base + col); hb[q] = *(const u32x4*)(base + 512 + col); ov[q] = *(const u32x4*)(base + 1536 + col); }
#pragma unroll
        for (int q = 0; q < 4; ++q) {
            float hv[8], ss = 0.f;
#pragma unroll
            for (int e = 0; e < 4; ++e) { hv[2 * e] = bf_lo(hf[q][e]) + bf_lo(hb[q][e]); hv[2 * e + 1] = bf_hi(hf[q][e]) + bf_hi(hb[q][e]); ss += hv[2 * e] * hv[2 * e] + hv[2 * e + 1] * hv[2 * e + 1]; }
            ss += __shfl_xor(ss, 1); ss += __shfl_xor(ss, 2); ss += __shfl_xor(ss, 4); ss += __shfl_xor(ss, 8);
            const float rs = rsqrtf(ss * (1.0f / 128.0f) + EPS);
            float y[8];
#pragma unroll
            for (int e = 0; e < 4; ++e) { const float o0 = bf_lo(ov[q][e]), o1 = bf_hi(ov[q][e]);
                y[2 * e] = hv[2 * e] * rs * nw[2 * e] * __builtin_amdgcn_rcpf(1.0f + __expf(-o0)); y[2 * e + 1] = hv[2 * e + 1] * rs * nw[2 * e + 1] * __builtin_amdgcn_rcpf(1.0f + __expf(-o1)); }
            u32x4 wv; wv.x = cvt_pk_bf16(y[0], y[1]); wv.y = cvt_pk_bf16(y[2], y[3]); wv.z = cvt_pk_bf16(y[4], y[5]); wv.w = cvt_pk_bf16(y[6], y[7]);
            *(u32x4*)(PROJ + (size_t)(t32 * 32 + wave * 4 + q) * NPROJ + 1536 + col) = wv;
        }
    }
}

__device__ __forceinline__ void final_phase(const Params& p) {
    const int tid = opaque_tid(); const ssq_t* ssq = (const ssq_t*)(p.ws + WS_SSQ) + 4 * MROWS; const bf16_t* XB = (const bf16_t*)(p.ws + WS_XB);
    const int c8 = (tid & 127) * 8;
    const f32x4 fw0 = *(const f32x4*)(p.fnorm_w + c8), fw1 = *(const f32x4*)(p.fnorm_w + c8 + 4);
    for (int r16 = blockIdx.x; r16 < MROWS / 16; r16 += gridDim.x) {
        u32x4 v[4]; float rs[4];
#pragma unroll
        for (int q = 0; q < 4; ++q) { const int row = r16 * 16 + q * 4 + (tid >> 7); v[q] = *(const u32x4*)(XB + (size_t)row * DM + c8); rs[q] = ssq_dec(ssq[row]); }
#pragma unroll
        for (int q = 0; q < 4; ++q) { const int row = r16 * 16 + q * 4 + (tid >> 7); const float r_ = rsqrtf(rs[q] * (1.0f / DM) + EPS);
            const f32x4 a = (f32x4){bf_lo(v[q].x), bf_hi(v[q].x), bf_lo(v[q].y), bf_hi(v[q].y)}, b = (f32x4){bf_lo(v[q].z), bf_hi(v[q].z), bf_lo(v[q].w), bf_hi(v[q].w)};
            float* op = p.out + (size_t)row * DM + c8;
            *(f32x4*)op = a * r_ * fw0; *(f32x4*)(op + 4) = b * r_ * fw1; }
    }
}

__device__ __forceinline__ void gates_phase(const Params& p, int l, const ssq_t* ssq) {
    const int tid = opaque_tid(), w = tid >> 6, lane = tid & 63, g = lane >> 4, c = lane & 15;
    const bf16_t* XB = (const bf16_t*)(p.ws + WS_XB); const bf16_t* Wg = (const bf16_t*)(p.ws + WS_WIN) + (size_t)l * NINP * DM + (size_t)NPROJ * DM;
    float* G = (float*)(p.ws + WS_G);
    for (int rb = blockIdx.x; rb < MROWS / 128; rb += gridDim.x) {
        const int row0 = rb * 128 + w * 16;
        const bf16_t* ap = XB + (size_t)(row0 + c) * DM + g * 8; const bf16_t* bp = Wg + (size_t)c * DM + g * 8;
        f32x4 acc = (f32x4){0.f, 0.f, 0.f, 0.f};
#pragma unroll 16
        for (int kk = 0; kk < 32; ++kk) { const bf16x8 a = *(const bf16x8*)(ap + kk * 32), b = *(const bf16x8*)(bp + kk * 32); acc = mfma16(a, b, acc); }
#pragma unroll
        for (int i = 0; i < 4; ++i) { const int row = row0 + 4 * g + i; G[(size_t)row * 16 + c] = acc[i] * rsqrtf(ssq_dec(ssq[row]) * (1.0f / DM) + EPS); }
    }
}

__global__ void __launch_bounds__(512, 2) fwd_kernel(Params p) {
    extern __shared__ __attribute__((aligned(16))) unsigned char smem[];
    LAS unsigned char* lds = (LAS unsigned char*)smem;
    unsigned char* ws = p.ws;
    bf16_t* XB = (bf16_t*)(ws + WS_XB); bf16_t* R1 = (bf16_t*)(ws + WS_R1); float* G = (float*)(ws + WS_G); ssq_t* ssq = (ssq_t*)(ws + WS_SSQ);
    volatile LAS unsigned* xst = (volatile LAS unsigned*)(lds + LDS_BYTES - 16);
    if (threadIdx.x < 4) xst[threadIdx.x] = 0u;
    __syncthreads();
    XcdBarrier xbar = xcd_barrier_post((unsigned*)(ws + WS_BAR), xst);
    for (int ph = p.ph_lo; ph < p.ph_hi; ++ph) {
        if (ph == 0) { if (PH_ON(0)) prep_phase(p, lds); if (REP(0)) prep_phase(p, lds); }
        else if (ph == 15) { if (PH_ON(8)) final_phase(p); }
        else {
            const int l = (ph - 1) / 7, sub = (ph - 1) % 7;
            pg8::StaticOrder S;
            if (sub == 0) { if (PH_ON(1)) {
                pg8::Gemm g; g.A = XB; g.Bt = (const bf16_t*)(ws + WS_WIN) + (size_t)l * NINP * DM; g.M = MROWS; g.N = NPROJ; g.K = DM; g.lda = DM;
                S.init(MROWS, NPROJ, gridDim.x, blockIdx.x);
                pg8::EpiProj E; E.P = R1; E.G = G; E.ssq = ssq + (size_t)(2 * l) * MROWS;
                pg8::gemm_phase(lds, g, S, E);
                if (REP(1)) pg8::gemm_phase(lds, g, S, E);
                gates_phase(p, l, E.ssq); }
            } else if (sub == 1) {
                { const int na_first = (blockIdx.x >> 3) & 1;
#pragma unroll 1
                  for (int pass = 0; pass < 2; ++pass) { if ((pass ^ na_first) == 1) na_phase(p, l, lds); else conv_phase(p, l); } }
            } else if (sub == 2) {
                if (PH_ON(4)) { mpre_phase(p, l); xcd_barrier(xbar); mlstm_phase(p, l, lds); }
                if (REP(4)) mlstm_phase(p, l, lds);
            } else if (sub == 3) {
                if (PH_ON(5)) combine_phase(p, l);
            } else if (sub == 4) { if (PH_ON(6)) {
                pg8::Gemm g; g.A = R1 + 1536; g.Bt = (const bf16_t*)(ws + WS_WOUT) + (size_t)l * DM * DM; g.M = MROWS; g.N = DM; g.K = DM; g.lda = NPROJ;
                S.init(MROWS, DM, gridDim.x, blockIdx.x);
                pg8::EpiResid E; E.XinF = (l == 0) ? p.x : nullptr; E.XinB = XB; E.XoutF = nullptr; E.XB = XB; E.ssq = ssq + (size_t)(2 * l + 1) * MROWS;
                pg8::gemm_phase(lds, g, S, E); }
            } else if (sub == 5) { if (PH_ON(7)) {
                pg8::Gemm g; g.A = XB; g.Bt = (const bf16_t*)(ws + WS_WFF1) + (size_t)l * DFF * DM; g.M = MROWS; g.N = DFF; g.K = DM; g.lda = DM;
                S.init(MROWS, DFF, gridDim.x, blockIdx.x);
                pg8::EpiFF1 E; E.H = R1; E.ssq = ssq + (size_t)(2 * l + 1) * MROWS;
                pg8::gemm_phase(lds, g, S, E);
                if (REP(7)) pg8::gemm_phase(lds, g, S, E); }
            } else { if (PH_ON(9)) {
                pg8::Gemm g; g.A = R1; g.Bt = (const bf16_t*)(ws + WS_WFF2) + (size_t)l * DM * DFF; g.M = MROWS; g.N = DM; g.K = DFF; g.lda = HLD;
                S.init(MROWS, DM, gridDim.x, blockIdx.x);
                pg8::EpiResid E; E.XinF = nullptr; E.XinB = XB; E.XoutF = nullptr; E.XB = XB; E.ssq = ssq + (size_t)(2 * l + 2) * MROWS;
                pg8::gemm_phase(lds, g, S, E); }
            }
        }
        if (ph + 1 < p.ph_hi) { if (p.ph_lo < 0) cg::this_grid().sync(); else xcd_barrier(xbar); }
        if (REP(10) && ph == 3) { for (int q = 0; q < 10; ++q) xcd_barrier(xbar); }
    }
}

extern "C" void kernel_launch(void* const* d_in, const int* in_sizes, int n_in, void* d_out, int out_size, void* d_ws, size_t ws_size, hipStream_t stream) {
    static int grid = 0;
    if (grid == 0) {
        int dev = 0, cus = 0, per_cu = 0;
        (void)hipGetDevice(&dev);
        (void)hipDeviceGetAttribute(&cus, hipDeviceAttributeMultiprocessorCount, dev);
        if (hipFuncSetAttribute((const void*)fwd_kernel, hipFuncAttributeMaxDynamicSharedMemorySize, LDS_BYTES) != hipSuccess) fprintf(stderr, "hipFuncSetAttribute failed\n");
        (void)hipOccupancyMaxActiveBlocksPerMultiprocessor(&per_cu, (const void*)fwd_kernel, 512, LDS_BYTES);
        if (per_cu < 1) { fprintf(stderr, "occupancy query says %d blocks per CU\n", per_cu); per_cu = 1; }
        grid = cus * per_cu;
        if (ws_size < WS_END) fprintf(stderr, "workspace too small: %zu < %zu\n", ws_size, (size_t)WS_END);
    }
    Params p{};
    p.x = (const float*)d_in[0]; p.norm1_w = (const float*)d_in[1]; p.w_in = (const float*)d_in[2]; p.conv_w = (const float*)d_in[3]; p.conv_b = (const float*)d_in[4];
    p.gate_b = (const float*)d_in[5]; p.mnorm_w = (const float*)d_in[6]; p.rpb = (const float*)d_in[7]; p.w_out = (const float*)d_in[8]; p.norm2_w = (const float*)d_in[9];
    p.w_ff1 = (const float*)d_in[10]; p.w_ff2 = (const float*)d_in[11]; p.fnorm_w = (const float*)d_in[12];
    p.out = (float*)d_out; p.ws = (unsigned char*)d_ws;
    (void)hipMemsetAsync((unsigned char*)d_ws + WS_BAR, 0, 16384, stream);
#if MULTI_LAUNCH
    for (int ph = 0; ph < 16; ++ph) { p.ph_lo = ph; p.ph_hi = ph + 1; hipLaunchKernelGGL(fwd_kernel, dim3(grid), dim3(512), LDS_BYTES, stream, p); }
#else
    p.ph_lo = 0; p.ph_hi = 16;
    void* args[] = {&p};
    hipError_t e = hipLaunchCooperativeKernel((const void*)fwd_kernel, dim3(grid), dim3(512), args, LDS_BYTES, stream);
    if (e != hipSuccess) fprintf(stderr, "cooperative launch failed: %s (grid %d)\n", hipGetErrorString(e), grid);
#endif
}
```

```cpp
#include <hip/hip_runtime.h>
#include <hip/hip_cooperative_groups.h>
#include <cstdio>
namespace cg = cooperative_groups;

#ifndef MULTI_LAUNCH
#define MULTI_LAUNCH 0
#endif
#ifndef PHASE_MASK
#define PHASE_MASK 0xffff
#endif
#define PH_ON(k) ((PHASE_MASK >> (k)) & 1)
#ifndef REPEAT_MASK
#define REPEAT_MASK 0
#endif
#define REP(k) ((REPEAT_MASK >> (k)) & 1)

#define LAS __attribute__((address_space(3)))
typedef unsigned short bf16_t;
typedef short bf16x8 __attribute__((ext_vector_type(8)));
typedef short s16x4 __attribute__((ext_vector_type(4)));
typedef float f32x4 __attribute__((ext_vector_type(4)));
typedef unsigned u32x4 __attribute__((ext_vector_type(4)));
typedef unsigned u32x2 __attribute__((ext_vector_type(2)));
typedef unsigned ssq_t;
__device__ __forceinline__ ssq_t ssq_enc(float s) { return (ssq_t)(s * 1024.0f + 0.5f); }
__device__ __forceinline__ float ssq_dec(ssq_t v) { return (float)v * (1.0f / 1024.0f); }

constexpr int MROWS = 32768, DM = 1024, SEQ = 4096, NPROJ = 3584, NINP = 3840, DFF = 4096, HLD = 4160;
constexpr int LDS_BYTES = 163840;
constexpr float EPS = 1e-6f;

constexpr size_t WS_WIN = 0;
constexpr size_t WS_WOUT = WS_WIN + (size_t)2 * NINP * DM * 2;
constexpr size_t WS_WFF1 = WS_WOUT + (size_t)2 * DM * DM * 2;
constexpr size_t WS_WFF2 = WS_WFF1 + (size_t)2 * DFF * DM * 2;
constexpr size_t WS_XB = WS_WFF2 + (size_t)2 * DM * DFF * 2;
constexpr size_t WS_G = WS_XB + (size_t)MROWS * DM * 2;
constexpr size_t WS_SSQ = WS_G + (size_t)MROWS * 16 * 4;
constexpr size_t WS_R1 = WS_SSQ + (size_t)5 * MROWS * 8;
constexpr size_t WS_BAR = WS_R1 + (size_t)MROWS * HLD * 2;
constexpr size_t WS_PBUF = WS_BAR + 16384;
constexpr size_t WS_SCAL = WS_PBUF + (size_t)4096 * 8192;
constexpr size_t WS_QKC = WS_SCAL + (size_t)4096 * 192 * 4;
constexpr size_t WS_END = WS_QKC + (size_t)MROWS * DM * 2;

struct Params {
    const float* x; const float* norm1_w; const float* w_in; const float* conv_w; const float* conv_b; const float* gate_b;
    const float* mnorm_w; const float* rpb; const float* w_out; const float* norm2_w; const float* w_ff1; const float* w_ff2; const float* fnorm_w;
    float* out; unsigned char* ws; int ph_lo, ph_hi;
};

typedef __bf16 bf16x2_t __attribute__((ext_vector_type(2)));
__device__ __forceinline__ unsigned cvt_pk_bf16(float lo, float hi) { bf16x2_t v; v[0] = (__bf16)lo; v[1] = (__bf16)hi; return __builtin_bit_cast(unsigned, v); }
__device__ __forceinline__ int opaque_tid() { int t = threadIdx.x; asm volatile("" : "+v"(t)); return t; }
__device__ __forceinline__ float bf_lo(unsigned w) { return __uint_as_float(w << 16); }
__device__ __forceinline__ float bf_hi(unsigned w) { return __uint_as_float(w & 0xffff0000u); }
__device__ __forceinline__ s16x4 tr_read(LAS unsigned char* p) { return __builtin_amdgcn_ds_read_tr16_b64_v4i16((LAS s16x4*)p); }
__device__ __forceinline__ bf16x8 cat4(s16x4 a, s16x4 b) { bf16x8 r; r[0] = a[0]; r[1] = a[1]; r[2] = a[2]; r[3] = a[3]; r[4] = b[0]; r[5] = b[1]; r[6] = b[2]; r[7] = b[3]; return r; }
#define LDS_BARRIER() do { asm volatile("s_waitcnt lgkmcnt(0)" ::: "memory"); __builtin_amdgcn_s_barrier(); asm volatile("" ::: "memory"); } while (0)
__device__ __forceinline__ f32x4 mfma16(bf16x8 a, bf16x8 b, f32x4 c) { return __builtin_amdgcn_mfma_f32_16x16x32_bf16(a, b, c, 0, 0, 0); }


#define XB_TMO      128
#define XB_XCNT(j)  (256  + 64 * (j))
#define XB_XSUB(j)  (1280 + 64 * (j))
#define XB_XGEN(j)  (2304 + 64 * (j))
#define XB_TOP      3328
#define XB_TOPGEN   3392
#define XCD_BAR_WORDS 3456
#define XB_SPIN_CAP (1u << 22)
__device__ __forceinline__ unsigned xb_ld(unsigned* p)              { return __hip_atomic_load(p, __ATOMIC_RELAXED, __HIP_MEMORY_SCOPE_AGENT); }
__device__ __forceinline__ unsigned xb_add(unsigned* p, unsigned v) { return __hip_atomic_fetch_add(p, v, __ATOMIC_RELAXED, __HIP_MEMORY_SCOPE_AGENT); }
__device__ __forceinline__ unsigned xb_xcc_id() { return (unsigned)__builtin_amdgcn_s_getreg((3 << 11) | 20) & 0xFu; }
#define XB_SPIN(cond, bar) do { unsigned _sp = 0; while (cond) { __builtin_amdgcn_s_sleep(1); \
    if ((++_sp & 255u) == 0u) { if (xb_ld(&(bar)[XB_TMO])) break; if (_sp > XB_SPIN_CAP) { atomicAdd(&(bar)[XB_TMO], 1u); break; } } } } while (0)
struct XcdBarrier { unsigned* bar; unsigned x; volatile LAS unsigned* st; };
__device__ __forceinline__ XcdBarrier xcd_barrier_post(unsigned* bar, volatile LAS unsigned* st) {
    XcdBarrier b; b.bar = bar; b.x = xb_xcc_id(); b.st = st;
    if (threadIdx.x == 0) (void)xb_add(&bar[XB_XCNT(b.x)], 1u);
    return b;
}
__device__ __forceinline__ void xcd_barrier_complete(unsigned* bar, unsigned x, unsigned& nloc, unsigned& nx) {
    const unsigned G = gridDim.x * gridDim.y * gridDim.z;
    unsigned sum, cnt, mine, sp = 0u;
    for (;;) {
        sum = 0u; cnt = 0u; mine = 0u;
#pragma unroll
        for (unsigned j = 0; j < 16; ++j) { const unsigned c = xb_ld(&bar[XB_XCNT(j)]); sum += c; cnt += (c > 0u) ? 1u : 0u; mine = (j == x) ? c : mine; }
        if (sum == G) break;
        __builtin_amdgcn_s_sleep(1);
        if ((++sp & 255u) == 0u) { if (xb_ld(&bar[XB_TMO])) break; if (sp > XB_SPIN_CAP) { atomicAdd(&bar[XB_TMO], 1u); break; } }
    }
    nloc = mine > 0u ? mine : 1u; nx = cnt > 0u ? cnt : 1u;
}
__device__ __forceinline__ void xcd_barrier(const XcdBarrier& b) {
    asm volatile("s_waitcnt vmcnt(0)" ::: "memory");
    __syncthreads();
    if (threadIdx.x == 0) {
        unsigned* bar = b.bar;
        __builtin_amdgcn_s_waitcnt(0);
        unsigned nloc = b.st[0], nx = b.st[1];
        if (nloc == 0u) { xcd_barrier_complete(bar, b.x, nloc, nx); b.st[0] = nloc; b.st[1] = nx; }
        const unsigned old = xb_add(&bar[XB_XSUB(b.x)], 1u);
        const unsigned gen = old / nloc;
        if (old + 1u == (gen + 1u) * nloc) {
            __builtin_amdgcn_fence(__ATOMIC_RELEASE, "agent");
            asm volatile("s_waitcnt vmcnt(0)" ::: "memory");
            const unsigned og = xb_add(&bar[XB_TOP], 1u);
            const unsigned tg = og / nx;
            if (og + 1u == (tg + 1u) * nx) xb_add(&bar[XB_TOPGEN], 1u);
            else XB_SPIN(xb_ld(&bar[XB_TOPGEN]) == tg, bar);
            __builtin_amdgcn_fence(__ATOMIC_ACQUIRE, "agent");
            xb_add(&bar[XB_XGEN(b.x)], 1u);
            asm volatile("s_waitcnt vmcnt(0)" ::: "memory");
        } else {
            XB_SPIN(xb_ld(&bar[XB_XGEN(b.x)]) == gen, bar);
            __builtin_amdgcn_fence(__ATOMIC_ACQUIRE, "agent");
            asm volatile("s_waitcnt vmcnt(0)" ::: "memory");
        }
    }
    __syncthreads();
}

namespace pg8 {
constexpr int BM = 256, BK = 64, HALF = 128, HTB = HALF * BK * 2, STAGE_BYTES = 8 * HTB, NXCD = 8, WGM = 8;
__device__ __forceinline__ int lds_byte(int r, int c) { const int st = (r >> 4) * 2 + (c >> 5), rr = r & 15, cc = c & 31, ob = rr * 64 + cc * 2; return st * 1024 + (ob ^ (((ob >> 9) & 1) << 5)); }
__device__ __forceinline__ void stage_rc(int b, int& R, int& C) { const int st = b / 1024, sb = b % 1024, swz = sb ^ (((sb >> 9) & 1) << 5); R = (st >> 1) * 16 + swz / 64; C = (st & 1) * 32 + (swz % 64) / 2; }
__device__ __forceinline__ int perm32(int rho) { const int n = rho >> 4, i = rho & 15; return 8 * (i >> 2) + 4 * n + (i & 3); }
struct Unit { int pm, pn; };
struct Gemm { const bf16_t* A; const bf16_t* Bt; int M, N, K, lda; };
struct StaticOrder {
    int nM, nN, nwg, G, c;
    __device__ void init(int M, int N, int G_, int c_) { nM = M / BM; nN = N / BM; nwg = nM * nN; G = G_; c = c_; }
    __device__ bool next(int i, Unit& u) const {
        const long L = (long)i * G + c; if (L >= nwg) return false;
        int wgid = (int)L; { const int q = nwg / NXCD, r = nwg % NXCD, xcd = wgid % NXCD, off = wgid / NXCD; wgid = (xcd < r ? xcd * (q + 1) : r * (q + 1) + (xcd - r) * q) + off; }
        const int nig = WGM * nN, gid = wgid / nig, fm = gid * WGM, gsz = (nM - fm) < WGM ? (nM - fm) : WGM;
        u.pm = fm + ((wgid % nig) % gsz); u.pn = (wgid % nig) / gsz; return true;
    }
};

struct EpiProj {
    bf16_t* P; float* G; const ssq_t* ssq;
    static constexpr bool HAS_PRE = true;
    __device__ __forceinline__ void pre(const Unit& u, int wr, int fr, ssq_t (&pv)[8]) const {
        const int row0 = u.pm * BM + wr * 64 + fr;
#pragma unroll
        for (int ai = 0; ai < 2; ++ai)
#pragma unroll
            for (int m = 0; m < 4; ++m) pv[ai * 4 + m] = ssq[row0 + ai * HALF + m * 16];
    }
    __device__ __forceinline__ void operator()(const f32x4 (&acc)[2][2][4][2], const Unit& u, int wr, int wc, int fr, int fq, const ssq_t (&pv)[8]) const {
        const int row0 = u.pm * BM + wr * 64 + fr;
#pragma unroll
        for (int ai = 0; ai < 2; ++ai)
#pragma unroll
            for (int m = 0; m < 4; ++m) {
                const int row = row0 + ai * HALF + m * 16;
                const float rs = rsqrtf(ssq_dec(pv[ai * 4 + m]) * (1.0f / DM) + EPS);
                bf16_t* rowp = P + (size_t)row * NPROJ + u.pn * BM + wc * 32 + 8 * fq;
#pragma unroll
                for (int bj = 0; bj < 2; ++bj) { const f32x4 v0 = acc[ai][bj][m][0] * rs, v1 = acc[ai][bj][m][1] * rs;
                    u32x4 w; w.x = cvt_pk_bf16(v0[0], v0[1]); w.y = cvt_pk_bf16(v0[2], v0[3]); w.z = cvt_pk_bf16(v1[0], v1[1]); w.w = cvt_pk_bf16(v1[2], v1[3]);
                    *(u32x4*)(rowp + bj * HALF) = w; }
            }
    }
};
struct EpiResid { static constexpr bool INPLACE = true;
    const float* XinF; const bf16_t* XinB; float* XoutF; bf16_t* XB; ssq_t* ssq;
    static constexpr bool HAS_PRE = false;
    __device__ __forceinline__ void pre(const Unit&, int, int, ssq_t (&)[8]) const {}
    __device__ __forceinline__ void operator()(const f32x4 (&acc)[2][2][4][2], const Unit& u, int wr, int wc, int fr, int fq, const ssq_t (&)[8]) const {
        const int row0 = u.pm * BM + wr * 64 + fr, col0 = u.pn * BM + wc * 32 + 8 * fq;
#pragma unroll
        for (int ai = 0; ai < 2; ++ai) {
            f32x4 xo[4][2][2];
            if (XinF) {
#pragma unroll
                for (int m = 0; m < 4; ++m)
#pragma unroll
                    for (int bj = 0; bj < 2; ++bj) { const size_t off = (size_t)(row0 + ai * HALF + m * 16) * DM + col0 + bj * HALF; xo[m][bj][0] = *(const f32x4*)(XinF + off); xo[m][bj][1] = *(const f32x4*)(XinF + off + 4); }
            } else {
                u32x4 xb[4][2];
#pragma unroll
                for (int m = 0; m < 4; ++m)
#pragma unroll
                    for (int bj = 0; bj < 2; ++bj) xb[m][bj] = *(const u32x4*)(XinB + (size_t)(row0 + ai * HALF + m * 16) * DM + col0 + bj * HALF);
#pragma unroll
                for (int m = 0; m < 4; ++m)
#pragma unroll
                    for (int bj = 0; bj < 2; ++bj) { const u32x4 t = xb[m][bj]; xo[m][bj][0] = (f32x4){bf_lo(t.x), bf_hi(t.x), bf_lo(t.y), bf_hi(t.y)}; xo[m][bj][1] = (f32x4){bf_lo(t.z), bf_hi(t.z), bf_lo(t.w), bf_hi(t.w)}; }
            }
#pragma unroll
            for (int m = 0; m < 4; ++m) {
                const int row = row0 + ai * HALF + m * 16; float s = 0.f;
#pragma unroll
                for (int bj = 0; bj < 2; ++bj) { const size_t off = (size_t)row * DM + col0 + bj * HALF;
                    const f32x4 v0 = xo[m][bj][0] + acc[ai][bj][m][0], v1 = xo[m][bj][1] + acc[ai][bj][m][1];
                    if (XoutF) { *(f32x4*)(XoutF + off) = v0; *(f32x4*)(XoutF + off + 4) = v1; }
                    if (XB) { u32x4 w; w.x = cvt_pk_bf16(v0[0], v0[1]); w.y = cvt_pk_bf16(v0[2], v0[3]); w.z = cvt_pk_bf16(v1[0], v1[1]); w.w = cvt_pk_bf16(v1[2], v1[3]);
                        *(u32x4*)(XB + off) = w; }
                    s += (v0[0] * v0[0] + v0[1] * v0[1]) + (v0[2] * v0[2] + v0[3] * v0[3]) + (v1[0] * v1[0] + v1[1] * v1[1]) + (v1[2] * v1[2] + v1[3] * v1[3]); }
                s += __shfl_xor(s, 16); s += __shfl_xor(s, 32);
                if (fq == 0) atomicAdd(ssq + row, ssq_enc(s));
            }
        }
    }
};
struct EpiFF1 {
    bf16_t* H; const ssq_t* ssq;
    static constexpr bool HAS_PRE = true;
    __device__ __forceinline__ void pre(const Unit& u, int wr, int fr, ssq_t (&pv)[8]) const {
        const int row0 = u.pm * BM + wr * 64 + fr;
#pragma unroll
        for (int ai = 0; ai < 2; ++ai)
#pragma unroll
            for (int m = 0; m < 4; ++m) pv[ai * 4 + m] = ssq[row0 + ai * HALF + m * 16];
    }
    __device__ __forceinline__ void operator()(const f32x4 (&acc)[2][2][4][2], const Unit& u, int wr, int wc, int fr, int fq, const ssq_t (&pv)[8]) const {
        const int row0 = u.pm * BM + wr * 64 + fr, col0 = u.pn * BM + wc * 32 + 8 * fq;
#pragma unroll
        for (int ai = 0; ai < 2; ++ai)
#pragma unroll
            for (int m = 0; m < 4; ++m) {
                const int row = row0 + ai * HALF + m * 16;
                const float rs = rsqrtf(ssq_dec(pv[ai * 4 + m]) * (1.0f / DM) + EPS);
                bf16_t* rowp = H + (size_t)row * HLD + col0;
#pragma unroll
                for (int bj = 0; bj < 2; ++bj) { f32x4 v0 = acc[ai][bj][m][0] * rs, v1 = acc[ai][bj][m][1] * rs;
#pragma unroll
                    for (int j = 0; j < 4; ++j) { const float a = fmaxf(v0[j], 0.f), b = fmaxf(v1[j], 0.f); v0[j] = a * a; v1[j] = b * b; }
                    u32x4 w; w.x = cvt_pk_bf16(v0[0], v0[1]); w.y = cvt_pk_bf16(v0[2], v0[3]); w.z = cvt_pk_bf16(v1[0], v1[1]); w.w = cvt_pk_bf16(v1[2], v1[3]);
                    *(u32x4*)(rowp + bj * HALF) = w; }
            }
    }
};

template <class Epi>
__device__ __forceinline__ void gemm_phase(LAS unsigned char* lds, const Gemm g, const StaticOrder& S, const Epi& E) {
    const int tid = opaque_tid(), wid = __builtin_amdgcn_readfirstlane(tid >> 6), lane = tid & 63, wr = wid >> 2, wc = wid & 3, fr = lane & 15, fq = lane >> 4;
    const int K = g.K, nt = K / BK, lda = g.lda;
    unsigned voffA[2], voffB[2];
#pragma unroll
    for (int i = 0; i < 2; ++i) { int R, C; stage_rc(tid * 16 + i * 8192, R, C); const int Rb = (R & ~31) + perm32(R & 31);
        voffA[i] = (unsigned)(R * lda + C) * 2u; voffB[i] = (unsigned)(Rb * K + C) * 2u; }
    const size_t kstep = (size_t)(BK * 2);
    const size_t hstepA = (size_t)HALF * lda * 2, hstepB = (size_t)HALF * K * 2;
    const size_t tstepA = 2 * hstepA, tstepB = 2 * hstepB;
    const unsigned ldsw = (unsigned)wid * 1024u;
    const int aoff = lds_byte(wr * 64 + fr, fq * 8), boff = lds_byte(wc * 32 + fr, fq * 8);
#define PG8_SA(b, h) (((b) * 2 + (h)) * HTB)
#define PG8_SB(b, h) ((4 + (b) * 2 + (h)) * HTB)
#define PG8_STAGE(bufoff, gbase, voff) do { _Pragma("unroll") for (int _i = 0; _i < 2; ++_i) \
        __builtin_amdgcn_global_load_lds((const unsigned*)((const char*)(gbase) + (voff)[_i]), (LAS unsigned*)(lds + (bufoff) + ldsw + _i * 8192), 16, 0, 0); } while (0)
#define PG8_LDA(dst, b, h) do { _Pragma("unroll") for (int m = 0; m < 4; ++m) _Pragma("unroll") for (int k = 0; k < 2; ++k) dst[m][k] = *(const LAS bf16x8*)(lds + PG8_SA(b, h) + aoff + m * 2048 + k * 1024); } while (0)
#define PG8_LDB(dst, b, h) do { _Pragma("unroll") for (int n = 0; n < 2; ++n) _Pragma("unroll") for (int k = 0; k < 2; ++k) dst[n][k] = *(const LAS bf16x8*)(lds + PG8_SB(b, h) + boff + n * 2048 + k * 1024); } while (0)
#define PG8_MMA(ai, bj, At, Bt) do { __builtin_amdgcn_s_setprio(1); _Pragma("unroll") for (int m = 0; m < 4; ++m) _Pragma("unroll") for (int n = 0; n < 2; ++n) _Pragma("unroll") for (int k = 0; k < 2; ++k) \
        acc[ai][bj][m][n] = __builtin_amdgcn_mfma_f32_16x16x32_bf16(Bt[n][k], At[m][k], acc[ai][bj][m][n], 0, 0, 0); __builtin_amdgcn_s_setprio(0); } while (0)
#define PG8_WAIT_V(n) asm volatile("s_waitcnt vmcnt(" #n ")" ::: "memory")
#define PG8_WAIT_L(n) asm volatile("s_waitcnt lgkmcnt(" #n ")" ::: "memory")
#define PG8_BAR __builtin_amdgcn_s_barrier()
#define PG8_SCHED __builtin_amdgcn_sched_barrier(0)
    Unit cur, nxt; int ui = 0;
    if (!S.next(0, cur)) return;
    f32x4 acc[2][2][4][2];
#pragma unroll
    for (int a = 0; a < 2; ++a)
#pragma unroll
        for (int b = 0; b < 2; ++b)
#pragma unroll
            for (int m = 0; m < 4; ++m)
#pragma unroll
                for (int n = 0; n < 2; ++n) acc[a][b][m][n] = (f32x4){0.f, 0.f, 0.f, 0.f};
    bf16x8 At[4][2], B0[2][2], B1[2][2];
    ssq_t pv[8] = {0u, 0u, 0u, 0u, 0u, 0u, 0u, 0u};
    const char* cA = (const char*)g.A + (size_t)cur.pm * tstepA; const char* cB = (const char*)g.Bt + (size_t)cur.pn * tstepB;
    PG8_STAGE(PG8_SB(0, 0), cB, voffB); PG8_STAGE(PG8_SA(0, 0), cA, voffA); PG8_STAGE(PG8_SB(0, 1), cB + hstepB, voffB); PG8_STAGE(PG8_SA(0, 1), cA + hstepA, voffA);
    if (wr == 1) PG8_BAR;
    PG8_WAIT_V(4); PG8_BAR;
    PG8_STAGE(PG8_SB(1, 0), cB + kstep, voffB); PG8_STAGE(PG8_SA(1, 0), cA + kstep, voffA); PG8_STAGE(PG8_SB(1, 1), cB + hstepB + kstep, voffB);
    PG8_WAIT_V(6); PG8_BAR;
    for (;;) {
        const bool has_next = S.next(ui + 1, nxt);
        const char* nA = has_next ? (const char*)g.A + (size_t)nxt.pm * tstepA : cA; const char* nB = has_next ? (const char*)g.Bt + (size_t)nxt.pn * tstepB : cB;
        for (int t = 0; t < nt; t += 2) {
            const bool last = (t == nt - 2);
            const char* a1 = cA + (size_t)(t + 1) * kstep;
            const char* a2 = last ? nA : cA + (size_t)(t + 2) * kstep; const char* b2 = last ? nB : cB + (size_t)(t + 2) * kstep;
            const char* a3 = a2 + kstep; const char* b3 = b2 + kstep;
            if (Epi::HAS_PRE && last) E.pre(cur, wr, fr, pv);
            PG8_LDB(B0, 0, 0); PG8_SCHED; PG8_LDA(At, 0, 0); PG8_STAGE(PG8_SA(1, 1), a1 + hstepA, voffA);
            PG8_WAIT_L(8); PG8_BAR; PG8_WAIT_L(0); PG8_MMA(0, 0, At, B0); PG8_BAR; PG8_SCHED;
            PG8_LDB(B1, 0, 1); PG8_STAGE(PG8_SB(0, 0), b2, voffB);
            PG8_BAR; PG8_WAIT_L(0); PG8_MMA(0, 1, At, B1); PG8_BAR;
            PG8_LDA(At, 0, 1); PG8_STAGE(PG8_SA(0, 0), a2, voffA);
            PG8_BAR; PG8_WAIT_L(0); PG8_MMA(1, 0, At, B0); PG8_BAR; PG8_SCHED;
            PG8_STAGE(PG8_SB(0, 1), b2 + hstepB, voffB);
            PG8_WAIT_V(6); PG8_BAR; PG8_MMA(1, 1, At, B1); PG8_BAR;
            PG8_LDB(B0, 1, 0); PG8_SCHED; PG8_LDA(At, 1, 0); PG8_STAGE(PG8_SA(0, 1), a2 + hstepA, voffA);
            PG8_WAIT_L(8); PG8_BAR; PG8_WAIT_L(0); PG8_MMA(0, 0, At, B0); PG8_BAR; PG8_SCHED;
            PG8_LDB(B1, 1, 1); PG8_STAGE(PG8_SB(1, 0), b3, voffB);
            PG8_BAR; PG8_WAIT_L(0); PG8_MMA(0, 1, At, B1); PG8_BAR;
            PG8_LDA(At, 1, 1); PG8_STAGE(PG8_SA(1, 0), a3, voffA);
            PG8_BAR; PG8_WAIT_L(0); PG8_MMA(1, 0, At, B0); PG8_BAR; PG8_SCHED;
            PG8_STAGE(PG8_SB(1, 1), b3 + hstepB, voffB);
            PG8_WAIT_V(6); PG8_BAR; PG8_MMA(1, 1, At, B1); PG8_BAR;
        }
        E(acc, cur, wr, wc, fr, fq, pv);
        if (!has_next) break;
#pragma unroll
        for (int a = 0; a < 2; ++a)
#pragma unroll
            for (int b = 0; b < 2; ++b)
#pragma unroll
                for (int m = 0; m < 4; ++m)
#pragma unroll
                    for (int n = 0; n < 2; ++n) acc[a][b][m][n] = (f32x4){0.f, 0.f, 0.f, 0.f};
        cur = nxt; cA = nA; cB = nB; ++ui;
    }
    PG8_WAIT_V(0);
    if (wr == 0) PG8_BAR;
    PG8_BAR;
#undef PG8_SA
#undef PG8_SB
#undef PG8_STAGE
#undef PG8_LDA
#undef PG8_LDB
#undef PG8_MMA
#undef PG8_WAIT_V
#undef PG8_WAIT_L
#undef PG8_BAR
#undef PG8_SCHED
}
}

struct WtDesc { const float* src; const float* scale; bf16_t* dst; int ldsrc, K, kt, nt, nsrc0, nvalid; };
__device__ __forceinline__ WtDesc wt_desc(const Params& p, int t) {
    WtDesc d; unsigned char* ws = p.ws;
    const int l = t / 3264; int r = t % 3264;
    if (r < 960) { d.kt = r / 60; d.nt = r % 60; d.src = p.w_in + (size_t)l * DM * 3600; d.ldsrc = 3600; d.scale = p.norm1_w + l * DM; d.dst = (bf16_t*)(ws + WS_WIN) + (size_t)l * NINP * DM; d.K = DM;
        const int n0 = d.nt * 64; if (n0 < 2048) { d.nsrc0 = n0; d.nvalid = 64; } else if (n0 < 3584) { d.nsrc0 = n0 + 16; d.nvalid = 64; } else if (n0 == 3584) { d.nsrc0 = 2048; d.nvalid = 16; } else { d.nsrc0 = 0; d.nvalid = 0; } }
    else if (r < 1216) { r -= 960; d.kt = r / 16; d.nt = r % 16; d.src = p.w_out + (size_t)l * DM * DM; d.ldsrc = DM; d.scale = nullptr; d.dst = (bf16_t*)(ws + WS_WOUT) + (size_t)l * DM * DM; d.K = DM; d.nsrc0 = d.nt * 64; d.nvalid = 64; }
    else if (r < 2240) { r -= 1216; d.kt = r / 64; d.nt = r % 64; d.src = p.w_ff1 + (size_t)l * DM * DFF; d.ldsrc = DFF; d.scale = p.norm2_w + l * DM; d.dst = (bf16_t*)(ws + WS_WFF1) + (size_t)l * DFF * DM; d.K = DM; d.nsrc0 = d.nt * 64; d.nvalid = 64; }
    else { r -= 2240; d.kt = r / 16; d.nt = r % 16; d.src = p.w_ff2 + (size_t)l * DFF * DM; d.ldsrc = DM; d.scale = nullptr; d.dst = (bf16_t*)(ws + WS_WFF2) + (size_t)l * DM * DFF; d.K = DFF; d.nsrc0 = d.nt * 64; d.nvalid = 64; }
    return d;
}
__device__ __forceinline__ void prep_phase(const Params& p, LAS unsigned char* lds, int lo, int hi, bool with_x) {
    const int tid = opaque_tid();
    unsigned char* ws = p.ws;
    constexpr int NT = 4;
    __syncthreads();
    for (int t = lo + blockIdx.x; t < hi; t += NT * gridDim.x) {
        WtDesc d[NT]; f32x4 v[NT][2]; float sc[NT][2]; bool has[NT];
#pragma unroll
        for (int q = 0; q < NT; ++q) { const int tq = t + q * gridDim.x; has[q] = tq < hi; d[q] = wt_desc(p, has[q] ? tq : t);
#pragma unroll
            for (int it = 0; it < 2; ++it) { const int kk = (tid >> 4) + 32 * it, n4 = (tid & 15) * 4;
                v[q][it] = (f32x4){0.f, 0.f, 0.f, 0.f};
                if (n4 < d[q].nvalid) v[q][it] = __builtin_nontemporal_load((const f32x4*)(d[q].src + (size_t)(d[q].kt * 64 + kk) * d[q].ldsrc + d[q].nsrc0 + n4));
                sc[q][it] = d[q].scale ? d[q].scale[d[q].kt * 64 + kk] : 1.0f; } }
#pragma unroll
        for (int q = 0; q < NT; ++q) { LAS float* T = (LAS float*)lds + q * 4160;
#pragma unroll
            for (int it = 0; it < 2; ++it) { const int kk = (tid >> 4) + 32 * it, n4 = (tid & 15) * 4;
#pragma unroll
                for (int e = 0; e < 4; ++e) T[(n4 + e) * 65 + kk] = v[q][it][e] * sc[q][it]; } }
        __syncthreads();
#pragma unroll
        for (int q = 0; q < NT; ++q) if (has[q]) { const LAS float* T = (const LAS float*)lds + q * 4160; const int n = tid >> 3, k8 = (tid & 7) * 8; float f[8];
#pragma unroll
            for (int e = 0; e < 8; ++e) f[e] = T[n * 65 + k8 + e];
            u32x4 w; w.x = cvt_pk_bf16(f[0], f[1]); w.y = cvt_pk_bf16(f[2], f[3]); w.z = cvt_pk_bf16(f[4], f[5]); w.w = cvt_pk_bf16(f[6], f[7]);
            *(u32x4*)(d[q].dst + (size_t)(d[q].nt * 64 + n) * d[q].K + d[q].kt * 64 + k8) = w; }
        __syncthreads();
    }
    if (!with_x) return;
    const int wave = tid >> 6, lane = tid & 63;
    bf16_t* XB = (bf16_t*)(ws + WS_XB); ssq_t* ssq = (ssq_t*)(ws + WS_SSQ);
    for (int t = blockIdx.x; t < MROWS / 16; t += gridDim.x) {
        f32x4 v[2][4];
#pragma unroll
        for (int q = 0; q < 2; ++q) { const f32x4* xr = (const f32x4*)(p.x + (size_t)(t * 16 + wave * 2 + q) * DM);
#pragma unroll
            for (int it = 0; it < 4; ++it) v[q][it] = __builtin_nontemporal_load(xr + it * 64 + lane); }
#pragma unroll
        for (int q = 0; q < 2; ++q) { const int row = t * 16 + wave * 2 + q; float s = 0.f;
#pragma unroll
            for (int it = 0; it < 4; ++it) { const f32x4 x = v[q][it]; s += (x[0] * x[0] + x[1] * x[1]) + (x[2] * x[2] + x[3] * x[3]);
                u32x2 w; w.x = cvt_pk_bf16(x[0], x[1]); w.y = cvt_pk_bf16(x[2], x[3]); *(u32x2*)(XB + (size_t)row * DM + (it * 64 + lane) * 4) = w; }
#pragma unroll
            for (int o = 32; o >= 1; o >>= 1) s += __shfl_xor(s, o);
            if (lane == 0) ssq[row] = ssq_enc(s); }
    }
    for (int i = blockIdx.x * 512 + tid; i < 4 * MROWS; i += gridDim.x * 512) ssq[MROWS + i] = 0u;
}

__device__ __forceinline__ void conv_phase(const Params& p, int l) {
    const int tid = opaque_tid(), cgp = tid & 127, rg = tid >> 7, c0 = cgp * 8;
    const bf16_t* PROJ = (const bf16_t*)(p.ws + WS_R1); bf16_t* QKC = (bf16_t*)(p.ws + WS_QKC);
    const float* cw = p.conv_w + (size_t)l * 3 * 1024; const float* cb = p.conv_b + (size_t)l * 1024;
    float w0[8], w1[8], w2[8], bb[8];
#pragma unroll
    for (int e = 0; e < 8; ++e) { w0[e] = cw[c0 + e]; w1[e] = cw[1024 + c0 + e]; w2[e] = cw[2048 + c0 + e]; bb[e] = cb[c0 + e]; }
    const float ksc = (c0 >= 512) ? 0.08838834764831845f : 1.0f;
    for (int t = blockIdx.x; t < MROWS / 16; t += gridDim.x) {
        const int r0 = t * 16 + rg * 4;
        u32x4 rw[6];
#pragma unroll
        for (int q = 0; q < 6; ++q) {
            const bool ok = !((q == 0 && (r0 & (SEQ - 1)) == 0) || (q == 5 && ((r0 + 3) & (SEQ - 1)) == SEQ - 1));
            rw[q] = (u32x4){0u, 0u, 0u, 0u};
            if (ok) rw[q] = *(const u32x4*)(PROJ + (size_t)(r0 - 1 + q) * NPROJ + c0);
        }
#pragma unroll
        for (int i = 0; i < 4; ++i) {
            float y[8];
#pragma unroll
            for (int e2 = 0; e2 < 4; ++e2) {
                const float a0 = bf_lo(rw[i][e2]), a1 = bf_hi(rw[i][e2]), b0 = bf_lo(rw[i + 1][e2]), b1 = bf_hi(rw[i + 1][e2]), c0f = bf_lo(rw[i + 2][e2]), c1f = bf_hi(rw[i + 2][e2]);
                y[2 * e2] = w0[2 * e2] * a0 + w1[2 * e2] * b0 + w2[2 * e2] * c0f + bb[2 * e2];
                y[2 * e2 + 1] = w0[2 * e2 + 1] * a1 + w1[2 * e2 + 1] * b1 + w2[2 * e2 + 1] * c1f + bb[2 * e2 + 1];
            }
#pragma unroll
            for (int e = 0; e < 8; ++e) y[e] = y[e] * __builtin_amdgcn_rcpf(1.0f + __expf(-y[e])) * ksc;
            u32x4 w; w.x = cvt_pk_bf16(y[0], y[1]); w.y = cvt_pk_bf16(y[2], y[3]); w.z = cvt_pk_bf16(y[4], y[5]); w.w = cvt_pk_bf16(y[6], y[7]);
            *(u32x4*)(QKC + (size_t)(r0 + i) * DM + c0) = w;
        }
    }
}

constexpr int NA_VSTR = 144;
constexpr int NA_KR = 0, NA_VR = 8 * 64 * 128, NA_MRG = NA_VR + 8 * 64 * NA_VSTR, NA_BT = NA_MRG + 4 * 18 * 64 * 4, NA_END = NA_BT + 15 * 32 * 4;
static_assert(NA_END <= LDS_BYTES - 16, "NA LDS");
__device__ __forceinline__ void na_phase(const Params& p, int l, LAS unsigned char* lds, bool probe = false) {
    const int tid = opaque_tid(), w = __builtin_amdgcn_readfirstlane(tid >> 6), lane = tid & 63, g = lane >> 4, c = lane & 15;
    bf16_t* PROJ = (bf16_t*)(p.ws + WS_R1);
    const int half = w >> 2, qt = w & 3, c0 = qt * 16;
    const int wsn = (c0 - 8 < 0) ? 0 : ((c0 - 8 > 32) ? 32 : c0 - 8);
    const int qc = c0 + c;
    const int cs = (qc - 8 < 0) ? 0 : ((qc - 8 > 48) ? 48 : qc - 8);
    int rc[2][4];
#pragma unroll
    for (int kt = 0; kt < 2; ++kt)
#pragma unroll
        for (int i = 0; i < 4; ++i) { const int kc = wsn + kt * 16 + 4 * g + i; rc[kt][i] = ((kc >= cs) && (kc < cs + 16)) ? (kc - qc + 15) : 31; }
    const int skey = tid >> 3, sch = tid & 7;
    const int skoff = skey * 128 + ((sch ^ (skey & 7)) * 16), svoff = skey * NA_VSTR + sch * 16;
    LAS float* bt = (LAS float*)(lds + NA_BT);
    for (int task = blockIdx.x; task < 256; task += gridDim.x) {
        const int head = task & 7, strip = (task >> 3) & 3, b = task >> 5;
        const int r0 = strip * 16;
        const bf16_t* kvbase = PROJ + ((size_t)b * SEQ + skey) * NPROJ + 2560 + head * 64 + sch * 8;
        int rs = (r0 - 4 < 0) ? 0 : ((r0 - 4 > 56) ? 56 : r0 - 4);
        __syncthreads();
        { u32x4 kk8[8], vv8[8];
#pragma unroll
          for (int j = 0; j < 8; ++j) { const bf16_t* src = kvbase + (size_t)(rs + j) * 64 * NPROJ; kk8[j] = *(const u32x4*)src; vv8[j] = *(const u32x4*)(src + 512); }
#pragma unroll
          for (int j = 0; j < 8; ++j) { const int slot = (rs + j) & 7; *(LAS u32x4*)(lds + NA_KR + slot * 8192 + skoff) = kk8[j]; *(LAS u32x4*)(lds + NA_VR + slot * 9216 + svoff) = vv8[j]; } }
        if (tid < 480) { const int br_ = tid >> 5, bc_ = tid & 31; bt[tid] = (bc_ < 31) ? p.rpb[(size_t)l * 8 * 465 + (size_t)head * 465 + br_ * 31 + bc_] * 1.4426950408889634f : -1e30f; }
        bf16x8 qf[2];
        { const size_t qtok = (size_t)b * SEQ + (size_t)r0 * 64 + c0 + c;
#pragma unroll
          for (int kk = 0; kk < 2; ++kk) qf[kk] = *(const bf16x8*)(PROJ + qtok * NPROJ + 2048 + head * 64 + kk * 32 + g * 8); }
        LDS_BARRIER();
        float breg[4][2][4]; int boff = 0x7fffffff;
#pragma unroll 1
        for (int ri = 0; ri < 16; ++ri) {
            const int r = r0 + ri;
            if (rs - r != boff) { boff = rs - r;
#pragma unroll
                for (int j = 0; j < 4; ++j)
#pragma unroll
                    for (int kt = 0; kt < 2; ++kt)
#pragma unroll
                        for (int i = 0; i < 4; ++i) breg[j][kt][i] = bt[(boff + 4 * half + j + 7) * 32 + rc[kt][i]]; }
            const size_t qtok = (size_t)b * SEQ + (size_t)r * 64 + c0 + c;
            const int rn = (ri < 15) ? r + 1 : r;
            const int rsn = (rn - 4 < 0) ? 0 : ((rn - 4 > 56) ? 56 : rn - 4);
            const bool slide = rsn != rs;
            const bf16_t* nsrc = kvbase + (size_t)(rsn + 7) * 64 * NPROJ;
            const u32x4 nk = *(const u32x4*)nsrc, nv = *(const u32x4*)(nsrc + 512);
            bf16x8 qfn[2];
            { const size_t qtokn = (size_t)b * SEQ + (size_t)rn * 64 + c0 + c;
#pragma unroll
              for (int kk = 0; kk < 2; ++kk) qfn[kk] = *(const bf16x8*)(PROJ + qtokn * NPROJ + 2048 + head * 64 + kk * 32 + g * 8); }
            __builtin_amdgcn_sched_barrier(0);
            f32x4 sc[4][2];
#pragma unroll
            for (int j = 0; j < 4; ++j) { const int slot = (rs + 4 * half + j) & 7;
#pragma unroll
                for (int kt = 0; kt < 2; ++kt) { f32x4 a = (f32x4){0.f, 0.f, 0.f, 0.f}; const int key = wsn + kt * 16 + c;
#pragma unroll
                    for (int kk = 0; kk < 2; ++kk) { const bf16x8 kfr = *(const LAS bf16x8*)(lds + NA_KR + slot * 8192 + key * 128 + (((kk * 4 + g) ^ (key & 7)) * 16)); a = mfma16(kfr, qf[kk], a); }
                    sc[j][kt] = a; } }
            float mrun = -1e30f;
#pragma unroll
            for (int j = 0; j < 4; ++j) {
#pragma unroll
                for (int kt = 0; kt < 2; ++kt)
#pragma unroll
                    for (int i = 0; i < 4; ++i) { const float sv = sc[j][kt][i] * 0.18033688011112042f + breg[j][kt][i]; sc[j][kt][i] = sv; mrun = fmaxf(mrun, sv); } }
            mrun = fmaxf(mrun, __shfl_xor(mrun, 16)); mrun = fmaxf(mrun, __shfl_xor(mrun, 32));
            float lrun = 0.f;
#pragma unroll
            for (int j = 0; j < 4; ++j)
#pragma unroll
                for (int kt = 0; kt < 2; ++kt)
#pragma unroll
                    for (int i = 0; i < 4; ++i) { const float pv = __builtin_amdgcn_exp2f(sc[j][kt][i] - mrun); sc[j][kt][i] = pv; lrun += pv; }
            lrun += __shfl_xor(lrun, 16); lrun += __shfl_xor(lrun, 32);
            f32x4 O[4];
#pragma unroll
            for (int dt = 0; dt < 4; ++dt) O[dt] = (f32x4){0.f, 0.f, 0.f, 0.f};
#pragma unroll
            for (int j = 0; j < 4; ++j) { const int slot = (rs + 4 * half + j) & 7;
                u32x4 pw; pw.x = cvt_pk_bf16(sc[j][0][0], sc[j][0][1]); pw.y = cvt_pk_bf16(sc[j][0][2], sc[j][0][3]); pw.z = cvt_pk_bf16(sc[j][1][0], sc[j][1][1]); pw.w = cvt_pk_bf16(sc[j][1][2], sc[j][1][3]);
                const bf16x8 pf = __builtin_bit_cast(bf16x8, pw);
                LAS unsigned char* vb = lds + NA_VR + slot * 9216 + (wsn + 4 * g + (c >> 2)) * NA_VSTR + (c & 3) * 8;
#pragma unroll
                for (int dt = 0; dt < 4; ++dt) { const s16x4 t0 = tr_read(vb + dt * 32), t1 = tr_read(vb + 16 * NA_VSTR + dt * 32); O[dt] = mfma16(cat4(t0, t1), pf, O[dt]); }
            }
            LDS_BARRIER();
            LAS float* MRG = (LAS float*)(lds + NA_MRG) + qt * 18 * 64 + lane;
            if (half == 1) { MRG[0] = mrun; MRG[64] = lrun;
#pragma unroll
                for (int dt = 0; dt < 4; ++dt)
#pragma unroll
                    for (int i = 0; i < 4; ++i) MRG[(2 + dt * 4 + i) * 64] = O[dt][i]; }
            if (slide) { const int slot = (rsn + 7) & 7; *(LAS u32x4*)(lds + NA_KR + slot * 8192 + skoff) = nk; *(LAS u32x4*)(lds + NA_VR + slot * 9216 + svoff) = nv; }
            LDS_BARRIER();
            if (half == 0) {
                const float m1 = MRG[0], l1 = MRG[64];
                const float m = fmaxf(mrun, m1), a0 = __builtin_amdgcn_exp2f(mrun - m), a1 = __builtin_amdgcn_exp2f(m1 - m);
                const float inv = __builtin_amdgcn_rcpf(lrun * a0 + l1 * a1);
#pragma unroll
                for (int dt = 0; dt < 4; ++dt) { f32x4 o;
#pragma unroll
                    for (int i = 0; i < 4; ++i) o[i] = (O[dt][i] * a0 + MRG[(2 + dt * 4 + i) * 64] * a1) * inv;
                    u32x2 wv; wv.x = cvt_pk_bf16(o[0], o[1]); wv.y = cvt_pk_bf16(o[2], o[3]);
                    if (probe) *(u32x2*)(PROJ + (size_t)MROWS * NPROJ + qtok * 512 + head * 64 + dt * 16 + 4 * g) = wv; else *(u32x2*)(PROJ + qtok * NPROJ + 2048 + head * 64 + dt * 16 + 4 * g) = wv; }
            }
            rs = rsn; qf[0] = qfn[0]; qf[1] = qfn[1];
        }
    }
    __syncthreads();
}

constexpr int ML_QSTR = 272, ML_VSTR = 112, ML_PSTR = 144, ML_SCB = 1536;
constexpr int ML_QS = 0, ML_KS = ML_QS + 2 * 64 * ML_QSTR, ML_VS = ML_KS + 2 * 64 * ML_QSTR, ML_VG = ML_VS + 2 * 64 * ML_VSTR, ML_PS = ML_VG + 2 * 64 * ML_VSTR,
              ML_CS = ML_PS + 2 * 64 * ML_PSTR, ML_SC = ML_CS + 2 * 48 * ML_QSTR, ML_END = ML_SC + 3 * ML_SCB;
static_assert(ML_END <= LDS_BYTES - 16, "mLSTM LDS");
#define ML_TOK(n, j) (tokb + (size_t)(dir ? (SEQ - 1 - ((n) * 64 + (j))) : ((n) * 64 + (j))))
__device__ __forceinline__ void mpre_phase(const Params& p, int l) {
    const int tid = opaque_tid(), w = tid >> 6, lane = tid & 63, g = lane >> 4, c = lane & 15;
    const bf16_t* QKC = (const bf16_t*)(p.ws + WS_QKC); const float* G = (const float*)(p.ws + WS_G); bf16_t* PBUF = (bf16_t*)(p.ws + WS_PBUF);
    for (int inst = blockIdx.x * 8 + w; inst < 4096; inst += gridDim.x * 8) {
        const int n = inst & 63, dir = (inst >> 6) & 1, h = (inst >> 7) & 3, b = inst >> 9;
        const size_t tokb = (size_t)b * SEQ;
        const size_t tk = ML_TOK(n, lane);
        const float ig = G[tk * 16 + (2 * dir) * 4 + h] + p.gate_b[l * 16 + (2 * dir) * 4 + h], fp = G[tk * 16 + (2 * dir + 1) * 4 + h] + p.gate_b[l * 16 + (2 * dir + 1) * 4 + h];
        bf16x8 kf[4][4], qf[4][4];
#pragma unroll
        for (int mt = 0; mt < 4; ++mt) { const size_t tkm = ML_TOK(n, 16 * mt + c);
#pragma unroll
            for (int kk = 0; kk < 4; ++kk) { kf[mt][kk] = *(const bf16x8*)(QKC + tkm * DM + 512 + h * 128 + kk * 32 + g * 8); qf[mt][kk] = *(const bf16x8*)(QKC + tkm * DM + h * 128 + kk * 32 + g * 8); } }
        float bcum = fminf(fp, 0.f) - __logf(1.0f + __expf(-fabsf(fp)));
#pragma unroll
        for (int o = 1; o < 64; o <<= 1) { const float t_ = __shfl_up(bcum, o); if (lane >= o) bcum += t_; }
        const float u = ig - bcum; float cm = u;
#pragma unroll
        for (int o = 1; o < 64; o <<= 1) { const float t_ = __shfl_up(cm, o); if (lane >= o) cm = fmaxf(cm, t_); }
        { float* sl = (float*)(p.ws + WS_SCAL) + (size_t)inst * 192; sl[lane] = bcum; sl[64 + lane] = u; sl[128 + lane] = cm; }
        bf16_t* pb = PBUF + (size_t)inst * 4096;
#pragma unroll
        for (int mt = 0; mt < 4; ++mt)
#pragma unroll
            for (int nt = 0; nt < 4; ++nt) { u32x2 pw = (u32x2){0u, 0u};
                if (mt <= nt) { f32x4 a = (f32x4){0.f, 0.f, 0.f, 0.f};
#pragma unroll
                    for (int kk = 0; kk < 4; ++kk) a = mfma16(kf[mt][kk], qf[nt][kk], a);
                    const float cmj = __shfl(cm, 16 * nt + c); float pv[4];
#pragma unroll
                    for (int i = 0; i < 4; ++i) { const int s_ = 16 * mt + 4 * g + i; const float us = __shfl(u, s_); pv[i] = (s_ <= 16 * nt + c) ? __expf(us - cmj) * a[i] : 0.f; }
                    pw.x = cvt_pk_bf16(pv[0], pv[1]); pw.y = cvt_pk_bf16(pv[2], pv[3]); }
                *(u32x2*)(pb + (16 * nt + c) * 64 + 16 * mt + 4 * g) = pw; }
    }
}

__device__ __forceinline__ void mlstm_phase(const Params& p, int l, LAS unsigned char* lds) {
    const int tid = opaque_tid(), w = __builtin_amdgcn_readfirstlane(tid >> 6), lane = tid & 63, g = lane >> 4, c = lane & 15;
    bf16_t* PROJ = (bf16_t*)(p.ws + WS_R1); const bf16_t* QKC = (const bf16_t*)(p.ws + WS_QKC); const float* G = (const float*)(p.ws + WS_G);
    const bf16_t* PBUF = (const bf16_t*)(p.ws + WS_PBUF);
    for (int task = blockIdx.x; task < 256; task += gridDim.x) {
        const int xq = task & 7, yq = task >> 3, vs = yq & 3, dir = (yq >> 2) & 1, bh = xq + 8 * (yq >> 3), h = bh & 3, b = bh >> 2;
        const size_t tokb = (size_t)b * SEQ;
        const bf16_t* pbase = PBUF + (size_t)(((b * 4 + h) * 2 + dir) * 64) * 4096 + (tid >> 3) * 64 + (tid & 7) * 8;
        const float gbi = p.gate_b[l * 16 + (2 * dir) * 4 + h], gbf = p.gate_b[l * 16 + (2 * dir + 1) * 4 + h];
        float mprev_chain = 0.f;
        __syncthreads();
        for (int i = tid; i < 48 * ML_QSTR / 4; i += 512) ((LAS unsigned*)(lds + ML_CS))[i] = 0u;
#define ML_GLOAD(n) do { const float* sl_ = scal + (size_t)(n) * 192; g_b = sl_[lane]; g_u = sl_[64 + lane]; g_cm = sl_[128 + lane]; } while (0)
#define ML_SCAN(sci) do { \
            const float Mj_ = fmaxf(mprev_chain, g_cm); \
            const float M63_ = __builtin_bit_cast(float, __builtin_amdgcn_readlane(__builtin_bit_cast(int, Mj_), 63)), tot_ = __builtin_bit_cast(float, __builtin_amdgcn_readlane(__builtin_bit_cast(int, g_b), 63)); \
            LAS float* sc_ = (LAS float*)(lds + ML_SC + (sci) * ML_SCB); \
            sc_[lane] = g_b; sc_[128 + lane] = Mj_; sc_[192 + lane] = __expf(g_u - M63_); sc_[320 + lane] = __expf(g_cm - Mj_); \
            if (lane == 0) { sc_[256] = __expf(mprev_chain - M63_); sc_[257] = mprev_chain; } \
            mprev_chain = tot_ + M63_; } while (0)
        const float* scal = (const float*)(p.ws + WS_SCAL) + (size_t)(((b * 4 + h) * 2 + dir) * 64) * 192;
        float g_b = 0.f, g_u = 0.f, g_cm = 0.f;
        if (w == 7) { ML_GLOAD(0); ML_SCAN(0); ML_GLOAD(1); ML_SCAN(1); }
        u32x4 qreg[1][2], kreg[1][2], vreg[1], preg[1];
        const long dtok = dir ? -1 : 1;
        const bf16_t* qp0 = QKC + ML_TOK(0, tid >> 4) * DM + h * 128 + (tid & 15) * 8;
        const bf16_t* vp = PROJ + ML_TOK(0, tid >> 2) * NPROJ + 1024 + h * 128 + vs * 32 + (tid & 3) * 8;
        const bf16_t* pp = pbase;
#define ML_LOAD(n, rs_) do { \
            qreg[rs_][0] = *(const u32x4*)(qp0); kreg[rs_][0] = *(const u32x4*)(qp0 + 512); \
            qreg[rs_][1] = *(const u32x4*)(qp0 + dtok * 32 * DM); kreg[rs_][1] = *(const u32x4*)(qp0 + dtok * 32 * DM + 512); \
            preg[rs_] = *(const u32x4*)(pp); \
            if (tid < 256) vreg[rs_] = *(const u32x4*)(vp); \
            qp0 += dtok * 64 * DM; vp += dtok * 64 * NPROJ; pp += 4096; } while (0)
#define ML_STORE(bufi, sci, rs_) do { \
            _Pragma("unroll") for (int it = 0; it < 2; ++it) { const int pc = it * 512 + tid, j = pc >> 4, part = pc & 15; \
                *(LAS u32x4*)(lds + ML_QS + (bufi) * 64 * ML_QSTR + j * ML_QSTR + part * 16) = qreg[rs_][it]; *(LAS u32x4*)(lds + ML_KS + (bufi) * 64 * ML_QSTR + j * ML_QSTR + part * 16) = kreg[rs_][it]; } \
            *(LAS u32x4*)(lds + ML_PS + (bufi) * 64 * ML_PSTR + (tid >> 3) * ML_PSTR + (tid & 7) * 16) = preg[rs_]; \
            const LAS float* scg_ = (const LAS float*)(lds + ML_SC + (sci) * ML_SCB + 192 * 4); \
            if (tid < 256) { const int j = tid >> 2, part = tid & 3; const float gj = scg_[j]; \
                *(LAS u32x4*)(lds + ML_VS + (bufi) * 64 * ML_VSTR + j * ML_VSTR + part * 16) = vreg[rs_]; u32x4 vg; \
                _Pragma("unroll") for (int e = 0; e < 4; ++e) vg[e] = cvt_pk_bf16(bf_lo(vreg[rs_][e]) * gj, bf_hi(vreg[rs_][e]) * gj); \
                *(LAS u32x4*)(lds + ML_VG + (bufi) * 64 * ML_VSTR + j * ML_VSTR + part * 16) = vg; } \
            else if (tid < 320) { const int j = tid - 256; const float gj = scg_[j]; \
                *(LAS u32x4*)(lds + ML_VS + (bufi) * 64 * ML_VSTR + j * ML_VSTR + 64) = (u32x4){0x3F80u, 0u, 0u, 0u}; *(LAS u32x4*)(lds + ML_VS + (bufi) * 64 * ML_VSTR + j * ML_VSTR + 80) = (u32x4){0u, 0u, 0u, 0u}; \
                *(LAS u32x4*)(lds + ML_VG + (bufi) * 64 * ML_VSTR + j * ML_VSTR + 64) = (u32x4){cvt_pk_bf16(gj, 0.f), 0u, 0u, 0u}; *(LAS u32x4*)(lds + ML_VG + (bufi) * 64 * ML_VSTR + j * ML_VSTR + 80) = (u32x4){0u, 0u, 0u, 0u}; } } while (0)
        ML_LOAD(0, 0);
        __syncthreads();
        ML_STORE(0, 0, 0);
        __syncthreads();
        f32x4 CT[2][3];
#pragma unroll
        for (int a = 0; a < 2; ++a)
#pragma unroll
            for (int v = 0; v < 3; ++v) CT[a][v] = (f32x4){0.f, 0.f, 0.f, 0.f};
        int s0 = 0, s1 = 1, s2 = 2;
        bf16_t* hp = PROJ + ML_TOK(0, 16 * (w & 3) + c) * NPROJ + dir * 512 + h * 128 + vs * 32 + 4 * g;
#define ML_STEP_BODY \
            LAS unsigned char* QS = lds + ML_QS + buf * 64 * ML_QSTR; LAS unsigned char* KS = lds + ML_KS + buf * 64 * ML_QSTR; \
            LAS unsigned char* VS = lds + ML_VS + buf * 64 * ML_VSTR; LAS unsigned char* VG = lds + ML_VG + buf * 64 * ML_VSTR; \
            LAS unsigned char* PS = lds + ML_PS + buf * 64 * ML_PSTR; LAS unsigned char* CS = lds + ML_CS + buf * 48 * ML_QSTR; LAS unsigned char* CSn = lds + ML_CS + nb * 48 * ML_QSTR; \
            const LAS float* sc = (const LAS float*)(lds + ML_SC + s0 * ML_SCB); \
            u32x2 hw[2] = {(u32x2){0u, 0u}, (u32x2){0u, 0u}}; \
            if (n + 1 < 64) ML_LOAD(n + 1, 0); \
            if (w == 7 && n + 2 < 64) ML_GLOAD(n + 2); \
            if (w < 4) { \
                const float mprev = sc[257]; \
                bf16x8 qa[4]; \
_Pragma("unroll") \
                for (int kk = 0; kk < 4; ++kk) qa[kk] = *(const LAS bf16x8*)(QS + (16 * w + c) * ML_QSTR + kk * 64 + g * 16); \
                bf16x8 pa[2]; \
_Pragma("unroll") \
                for (int kk = 0; kk < 2; ++kk) pa[kk] = *(const LAS bf16x8*)(PS + (16 * w + c) * ML_PSTR + kk * 64 + g * 16); \
                const int jj = 16 * w + c; const float Mj = sc[128 + jj]; \
                const float wi = __expf(mprev - Mj), em = __expf(-(sc[jj] + Mj)), rho = sc[320 + jj]; \
                f32x4 num[3]; \
_Pragma("unroll") \
                for (int vt = 0; vt < 3; ++vt) { f32x4 a = (f32x4){0.f, 0.f, 0.f, 0.f}, a2 = (f32x4){0.f, 0.f, 0.f, 0.f}; \
_Pragma("unroll") \
                    for (int kk = 0; kk < 4; ++kk) { const bf16x8 cf = *(const LAS bf16x8*)(CS + (16 * vt + c) * ML_QSTR + kk * 64 + g * 16); a = mfma16(cf, qa[kk], a); } \
_Pragma("unroll") \
                    for (int kk = 0; kk < 2; ++kk) { LAS unsigned char* vb = VS + (32 * kk + 8 * g + (c >> 2)) * ML_VSTR + vt * 32 + (c & 3) * 8; \
                        const s16x4 t0 = tr_read(vb), t1 = tr_read(vb + 4 * ML_VSTR); a2 = mfma16(cat4(t0, t1), pa[kk], a2); } \
                    num[vt] = a * wi + a2 * rho; } \
                const float den = __shfl(num[2][0], c); const float inv = __builtin_amdgcn_rcpf(fmaxf(fabsf(den), em)); \
_Pragma("unroll") \
                for (int vt = 0; vt < 2; ++vt) { const f32x4 o = num[vt] * inv; hw[vt].x = cvt_pk_bf16(o[0], o[1]); hw[vt].y = cvt_pk_bf16(o[2], o[3]); } \
            } else { \
                const int ww = w - 4; const float decay = sc[256]; \
_Pragma("unroll") \
                for (int a = 0; a < 2; ++a) \
_Pragma("unroll") \
                    for (int v = 0; v < 3; ++v) CT[a][v] = CT[a][v] * decay; \
_Pragma("unroll") \
                for (int kk = 0; kk < 2; ++kk) { bf16x8 af[2], bfr[3]; \
_Pragma("unroll") \
                    for (int a = 0; a < 2; ++a) { LAS unsigned char* kb = KS + (32 * kk + 8 * g + (c >> 2)) * ML_QSTR + (2 * ww + a) * 32 + (c & 3) * 8; af[a] = cat4(tr_read(kb), tr_read(kb + 4 * ML_QSTR)); } \
_Pragma("unroll") \
                    for (int v = 0; v < 3; ++v) { LAS unsigned char* vb = VG + (32 * kk + 8 * g + (c >> 2)) * ML_VSTR + v * 32 + (c & 3) * 8; bfr[v] = cat4(tr_read(vb), tr_read(vb + 4 * ML_VSTR)); } \
_Pragma("unroll") \
                    for (int a = 0; a < 2; ++a) \
_Pragma("unroll") \
                        for (int v = 0; v < 3; ++v) CT[a][v] = mfma16(af[a], bfr[v], CT[a][v]); } \
_Pragma("unroll") \
                for (int a = 0; a < 2; ++a) \
_Pragma("unroll") \
                    for (int v = 0; v < 3; ++v) { u32x2 cw; cw.x = cvt_pk_bf16(CT[a][v][0], CT[a][v][1]); cw.y = cvt_pk_bf16(CT[a][v][2], CT[a][v][3]); \
                        *(LAS u32x2*)(CSn + (16 * v + c) * ML_QSTR + (16 * (2 * ww + a) + 4 * g) * 2) = cw; } \
                if (w == 7 && n + 2 < 64) { ML_SCAN(s2); } \
            } \
            if (n + 1 < 64) ML_STORE(nb, s1, 0); \
            if (w < 4) { *(u32x2*)(hp) = hw[0]; *(u32x2*)(hp + 16) = hw[1]; } \
            LDS_BARRIER(); \
            { const int t_ = s0; s0 = s1; s1 = s2; s2 = t_; } \
            hp += dtok * 64 * NPROJ;
#pragma unroll 1
        for (int n2 = 0; n2 < 64; n2 += 2) {
            { constexpr int buf = 0, nb = 1; const int n = n2; ML_STEP_BODY }
            { constexpr int buf = 1, nb = 0; const int n = n2 + 1; ML_STEP_BODY }
        }
#undef ML_STEP_BODY
#undef ML_SCAN
#undef ML_GLOAD
#undef ML_LOAD
#undef ML_STORE
    }
}
#undef ML_TOK

__device__ __forceinline__ void combine_phase(const Params& p, int l) {
    const int tid = opaque_tid(), wave = tid >> 6, lane = tid & 63, col = lane * 8;
    bf16_t* PROJ = (bf16_t*)(p.ws + WS_R1);
    float nw[8];
#pragma unroll
    for (int e = 0; e < 8; ++e) nw[e] = p.mnorm_w[l * 512 + col + e];
    for (int t32 = blockIdx.x; t32 < MROWS / 32; t32 += gridDim.x) {
        u32x4 hf[4], hb[4], ov[4];
#pragma unroll
        for (int q = 0; q < 4; ++q) { const bf16_t* base = PROJ + (size_t)(t32 * 32 + wave * 4 + q) * NPROJ;
            hf[q] = *(const u32x4*)(base + col); hb[q] = *(const u32x4*)(base + 512 + col); ov[q] = *(const u32x4*)(base + 1536 + col); }
#pragma unroll
        for (int q = 0; q < 4; ++q) {
            float hv[8], ss = 0.f;
#pragma unroll
            for (int e = 0; e < 4; ++e) { hv[2 * e] = bf_lo(hf[q][e]) + bf_lo(hb[q][e]); hv[2 * e + 1] = bf_hi(hf[q][e]) + bf_hi(hb[q][e]); ss += hv[2 * e] * hv[2 * e] + hv[2 * e + 1] * hv[2 * e + 1]; }
            ss += __shfl_xor(ss, 1); ss += __shfl_xor(ss, 2); ss += __shfl_xor(ss, 4); ss += __shfl_xor(ss, 8);
            const float rs = rsqrtf(ss * (1.0f / 128.0f) + EPS);
            float y[8];
#pragma unroll
            for (int e = 0; e < 4; ++e) { const float o0 = bf_lo(ov[q][e]), o1 = bf_hi(ov[q][e]);
                y[2 * e] = hv[2 * e] * rs * nw[2 * e] * __builtin_amdgcn_rcpf(1.0f + __expf(-o0)); y[2 * e + 1] = hv[2 * e + 1] * rs * nw[2 * e + 1] * __builtin_amdgcn_rcpf(1.0f + __expf(-o1)); }
            u32x4 wv; wv.x = cvt_pk_bf16(y[0], y[1]); wv.y = cvt_pk_bf16(y[2], y[3]); wv.z = cvt_pk_bf16(y[4], y[5]); wv.w = cvt_pk_bf16(y[6], y[7]);
            *(u32x4*)(PROJ + (size_t)(t32 * 32 + wave * 4 + q) * NPROJ + 1536 + col) = wv;
        }
    }
}

__device__ __forceinline__ void final_phase(const Params& p) {
    const int tid = opaque_tid(); const ssq_t* ssq = (const ssq_t*)(p.ws + WS_SSQ) + 4 * MROWS; const bf16_t* XB = (const bf16_t*)(p.ws + WS_XB);
    const int c8 = (tid & 127) * 8;
    const f32x4 fw0 = *(const f32x4*)(p.fnorm_w + c8), fw1 = *(const f32x4*)(p.fnorm_w + c8 + 4);
    for (int r16 = blockIdx.x; r16 < MROWS / 16; r16 += gridDim.x) {
        u32x4 v[4]; float rs[4];
#pragma unroll
        for (int q = 0; q < 4; ++q) { const int row = r16 * 16 + q * 4 + (tid >> 7); v[q] = *(const u32x4*)(XB + (size_t)row * DM + c8); rs[q] = ssq_dec(ssq[row]); }
#pragma unroll
        for (int q = 0; q < 4; ++q) { const int row = r16 * 16 + q * 4 + (tid >> 7); const float r_ = rsqrtf(rs[q] * (1.0f / DM) + EPS);
            const f32x4 a = (f32x4){bf_lo(v[q].x), bf_hi(v[q].x), bf_lo(v[q].y), bf_hi(v[q].y)}, b = (f32x4){bf_lo(v[q].z), bf_hi(v[q].z), bf_lo(v[q].w), bf_hi(v[q].w)};
            float* op = p.out + (size_t)row * DM + c8;
            *(f32x4*)op = a * r_ * fw0; *(f32x4*)(op + 4) = b * r_ * fw1; }
    }
}

__device__ __forceinline__ void gates_phase(const Params& p, int l, const ssq_t* ssq) {
    const int tid = opaque_tid(), w = tid >> 6, lane = tid & 63, g = lane >> 4, c = lane & 15;
    const bf16_t* XB = (const bf16_t*)(p.ws + WS_XB); const bf16_t* Wg = (const bf16_t*)(p.ws + WS_WIN) + (size_t)l * NINP * DM + (size_t)NPROJ * DM;
    float* G = (float*)(p.ws + WS_G);
    for (int rb = blockIdx.x; rb < MROWS / 128; rb += gridDim.x) {
        const int row0 = rb * 128 + w * 16;
        const bf16_t* ap = XB + (size_t)(row0 + c) * DM + g * 8; const bf16_t* bp = Wg + (size_t)c * DM + g * 8;
        f32x4 acc = (f32x4){0.f, 0.f, 0.f, 0.f};
#pragma unroll 16
        for (int kk = 0; kk < 32; ++kk) { const bf16x8 a = *(const bf16x8*)(ap + kk * 32), b = *(const bf16x8*)(bp + kk * 32); acc = mfma16(a, b, acc); }
#pragma unroll
        for (int i = 0; i < 4; ++i) { const int row = row0 + 4 * g + i; G[(size_t)row * 16 + c] = acc[i] * rsqrtf(ssq_dec(ssq[row]) * (1.0f / DM) + EPS); }
    }
}

__global__ void __launch_bounds__(512, 2) fwd_kernel(Params p) {
    extern __shared__ __attribute__((aligned(16))) unsigned char smem[];
    LAS unsigned char* lds = (LAS unsigned char*)smem;
    unsigned char* ws = p.ws;
    bf16_t* XB = (bf16_t*)(ws + WS_XB); bf16_t* R1 = (bf16_t*)(ws + WS_R1); float* G = (float*)(ws + WS_G); ssq_t* ssq = (ssq_t*)(ws + WS_SSQ);
    volatile LAS unsigned* xst = (volatile LAS unsigned*)(lds + LDS_BYTES - 16);
    if (threadIdx.x < 4) xst[threadIdx.x] = 0u;
    __syncthreads();
    XcdBarrier xbar = xcd_barrier_post((unsigned*)(ws + WS_BAR), xst);
    for (int ph = p.ph_lo; ph < p.ph_hi; ++ph) {
        if (ph == 0) { prep_phase(p, lds, 0, 960, true); }
        else if (ph == 15) { if (PH_ON(8)) final_phase(p); }
        else {
            const int l = (ph - 1) / 7, sub = (ph - 1) % 7;
            pg8::StaticOrder S;
            if (sub == 0) { if (PH_ON(1)) {
                pg8::Gemm g; g.A = XB; g.Bt = (const bf16_t*)(ws + WS_WIN) + (size_t)l * NINP * DM; g.M = MROWS; g.N = NPROJ; g.K = DM; g.lda = DM;
                S.init(MROWS, NPROJ, gridDim.x, blockIdx.x);
                pg8::EpiProj E; E.P = R1; E.G = G; E.ssq = ssq + (size_t)(2 * l) * MROWS;
                pg8::gemm_phase(lds, g, S, E);
                if (REP(1)) pg8::gemm_phase(lds, g, S, E);
                gates_phase(p, l, E.ssq); }
            } else if (sub == 1) {
                { const int na_first = (blockIdx.x >> 3) & 1;
#pragma unroll 1
                  for (int pass = 0; pass < 2; ++pass) { if ((pass ^ na_first) == 1) na_phase(p, l, lds); else { conv_phase(p, l); if (l == 0) prep_phase(p, lds, 960, 6528, false); } } }
            } else if (sub == 2) {
                if (PH_ON(4)) { mpre_phase(p, l); xcd_barrier(xbar); mlstm_phase(p, l, lds); }
                if (REP(4)) mlstm_phase(p, l, lds);
            } else if (sub == 3) {
                if (PH_ON(5)) combine_phase(p, l);
            } else if (sub == 4) { if (PH_ON(6)) {
                pg8::Gemm g; g.A = R1 + 1536; g.Bt = (const bf16_t*)(ws + WS_WOUT) + (size_t)l * DM * DM; g.M = MROWS; g.N = DM; g.K = DM; g.lda = NPROJ;
                S.init(MROWS, DM, gridDim.x, blockIdx.x);
                pg8::EpiResid E; E.XinF = (l == 0) ? p.x : nullptr; E.XinB = XB; E.XoutF = nullptr; E.XB = XB; E.ssq = ssq + (size_t)(2 * l + 1) * MROWS;
                pg8::gemm_phase(lds, g, S, E); }
            } else if (sub == 5) { if (PH_ON(7)) {
                pg8::Gemm g; g.A = XB; g.Bt = (const bf16_t*)(ws + WS_WFF1) + (size_t)l * DFF * DM; g.M = MROWS; g.N = DFF; g.K = DM; g.lda = DM;
                S.init(MROWS, DFF, gridDim.x, blockIdx.x);
                pg8::EpiFF1 E; E.H = R1; E.ssq = ssq + (size_t)(2 * l + 1) * MROWS;
                pg8::gemm_phase(lds, g, S, E);
                if (REP(7)) pg8::gemm_phase(lds, g, S, E); }
            } else { if (PH_ON(9)) {
                pg8::Gemm g; g.A = R1; g.Bt = (const bf16_t*)(ws + WS_WFF2) + (size_t)l * DM * DFF; g.M = MROWS; g.N = DM; g.K = DFF; g.lda = HLD;
                S.init(MROWS, DM, gridDim.x, blockIdx.x);
                pg8::EpiResid E; E.XinF = nullptr; E.XinB = XB; E.XoutF = nullptr; E.XB = XB; E.ssq = ssq + (size_t)(2 * l + 2) * MROWS;
                pg8::gemm_phase(lds, g, S, E); }
            }
        }
        if (ph + 1 < p.ph_hi) { if (p.ph_lo < 0) cg::this_grid().sync(); else xcd_barrier(xbar); }
        if (REP(10) && ph == 3) { for (int q = 0; q < 10; ++q) xcd_barrier(xbar); }
    }
}

extern "C" void kernel_launch(void* const* d_in, const int* in_sizes, int n_in, void* d_out, int out_size, void* d_ws, size_t ws_size, hipStream_t stream) {
    static int grid = 0;
    if (grid == 0) {
        int dev = 0, cus = 0, per_cu = 0;
        (void)hipGetDevice(&dev);
        (void)hipDeviceGetAttribute(&cus, hipDeviceAttributeMultiprocessorCount, dev);
        if (hipFuncSetAttribute((const void*)fwd_kernel, hipFuncAttributeMaxDynamicSharedMemorySize, LDS_BYTES) != hipSuccess) fprintf(stderr, "hipFuncSetAttribute failed\n");
        (void)hipOccupancyMaxActiveBlocksPerMultiprocessor(&per_cu, (const void*)fwd_kernel, 512, LDS_BYTES);
        if (per_cu < 1) { fprintf(stderr, "occupancy query says %d blocks per CU\n", per_cu); per_cu = 1; }
        grid = cus * per_cu;
        if (ws_size < WS_END) fprintf(stderr, "workspace too small: %zu < %zu\n", ws_size, (size_t)WS_END);
    }
    Params p{};
    p.x = (const float*)d_in[0]; p.norm1_w = (const float*)d_in[1]; p.w_in = (const float*)d_in[2]; p.conv_w = (const float*)d_in[3]; p.conv_b = (const float*)d_in[4];
    p.gate_b = (const float*)d_in[5]; p.mnorm_w = (const float*)d_in[6]; p.rpb = (const float*)d_in[7]; p.w_out = (const float*)d_in[8]; p.norm2_w = (const float*)d_in[9];
    p.w_ff1 = (const float*)d_in[10]; p.w_ff2 = (const float*)d_in[11]; p.fnorm_w = (const float*)d_in[12];
    p.out = (float*)d_out; p.ws = (unsigned char*)d_ws;
    (void)hipMemsetAsync((unsigned char*)d_ws + WS_BAR, 0, 16384, stream);
#if MULTI_LAUNCH
    for (int ph = 0; ph < 16; ++ph) { p.ph_lo = ph; p.ph_hi = ph + 1; hipLaunchKernelGGL(fwd_kernel, dim3(grid), dim3(512), LDS_BYTES, stream, p); }
#else
    p.ph_lo = 0; p.ph_hi = 16;
    void* args[] = {&p};
    hipError_t e = hipLaunchCooperativeKernel((const void*)fwd_kernel, dim3(grid), dim3(512), args, LDS_BYTES, stream);
    if (e != hipSuccess) fprintf(stderr, "cooperative launch failed: %s (grid %d)\n", hipGetErrorString(e), grid);
#endif
}
```
